# Optimizing an MI355X kernel written in HIP

```python
import jax, jax.numpy as jnp
from jax import lax
import numpy as np

D_MODEL = 1024
BATCH = 2
SEQ = 8192
DEPTH = 2

N_MIXERS = 2
N_ATTN_LAYERS = (DEPTH + 1) // 2
N_GMLP_LAYERS = DEPTH // 2
HEAD_DIM = 64
N_Q_HEADS = D_MODEL // HEAD_DIM
N_KV_HEADS = 4
GQA_GROUP = N_Q_HEADS // N_KV_HEADS
WINDOW = 128
ROPE_THETA = 10000.0
Q_WIDTH = N_Q_HEADS * HEAD_DIM
KV_WIDTH = N_KV_HEADS * HEAD_DIM
QKV_WIDTH = Q_WIDTH + 2 * KV_WIDTH
CHUNK = 128
GMLP_WIDTH = 2 * D_MODEL
N_SGU_GROUPS = 8
SGU_GROUP_DIM = GMLP_WIDTH // N_SGU_GROUPS
N_EXPERT_GROUPS = 4
EXPERTS_PER_GROUP = 8
TOP_K_INNER = 2
EXPERT_FF = D_MODEL // 4
N_MOD = 6
DEEPNORM_ALPHA = (2.0 * DEPTH) ** 0.25
DEEPNORM_BETA = (8.0 * DEPTH) ** -0.25
LN_EPS = 1e-5

kernel_name = "hybrid_swa_sink_gmlp_hmoe_deepnorm_adaln"


def layer_norm(x, g, b):
    xf = x.astype(jnp.float32)
    mu = jnp.mean(xf, axis=-1, keepdims=True)
    var = jnp.mean(jnp.square(xf - mu), axis=-1, keepdims=True)
    y = (xf - mu) * lax.rsqrt(var + LN_EPS)
    return (y * g.astype(jnp.float32) + b.astype(jnp.float32)).astype(x.dtype)


def rope(x, cos, sin):
    xf = x.astype(jnp.float32)
    x1, x2 = jnp.split(xf, 2, axis=-1)
    return jnp.concatenate([x1 * cos - x2 * sin, x2 * cos + x1 * sin], axis=-1).astype(x.dtype)


def sliding_window_sink_attention(h, cos, sin, w_qkv, b_qkv, sinks, w_o, b_o):
    B, S, _ = h.shape
    nb = S // WINDOW
    qkv = h @ w_qkv + b_qkv
    q, k, v = jnp.split(qkv, [Q_WIDTH, Q_WIDTH + KV_WIDTH], axis=-1)
    q = rope(q.reshape(B, S, N_Q_HEADS, HEAD_DIM), cos, sin)
    k = rope(k.reshape(B, S, N_KV_HEADS, HEAD_DIM), cos, sin)
    v = v.reshape(B, S, N_KV_HEADS, HEAD_DIM)
    qb = q.reshape(B, nb, WINDOW, N_KV_HEADS, GQA_GROUP, HEAD_DIM)

    def band(t):
        tb = t.reshape(B, nb, WINDOW, N_KV_HEADS, HEAD_DIM)
        prev = jnp.pad(tb, ((0, 0), (1, 0), (0, 0), (0, 0), (0, 0)))[:, :-1]
        return jnp.concatenate([prev, tb], axis=2)

    kb, vb = band(k), band(v)
    scores = jnp.einsum('bnqkgd,bnskd->bnkgqs', qb, kb,
                        preferred_element_type=jnp.float32) * (HEAD_DIM ** -0.5)
    qi = jnp.arange(WINDOW)[:, None] + WINDOW
    kj = jnp.arange(2 * WINDOW)[None, :]
    in_band = (kj <= qi) & (kj > qi - WINDOW)
    blk_valid = (jnp.arange(nb)[:, None, None] > 0) | (kj[None] >= WINDOW)
    mask = in_band[None] & blk_valid
    scores = jnp.where(mask[None, :, None, None], scores, -jnp.inf)
    sink = sinks.astype(jnp.float32).reshape(1, 1, N_KV_HEADS, GQA_GROUP, 1, 1)
    m = jnp.maximum(jnp.max(scores, axis=-1, keepdims=True), sink)
    p = jnp.exp(scores - m)
    denom = jnp.sum(p, axis=-1, keepdims=True) + jnp.exp(sink - m)
    probs = (p / denom).astype(v.dtype)
    o = jnp.einsum('bnkgqs,bnskd->bnqkgd', probs, vb)
    return o.reshape(B, S, Q_WIDTH) @ w_o + b_o


def chunked_spatial_gating(h, w_in, b_in, sgu_ln_g, sgu_ln_b, w_s, b_s, w_out, b_out):
    B, S, _ = h.shape
    nc = S // CHUNK
    z = jax.nn.gelu(h @ w_in + b_in, approximate=False)
    u, v = jnp.split(z, 2, axis=-1)
    v = layer_norm(v, sgu_ln_g, sgu_ln_b)
    v = v.reshape(B, nc, CHUNK, N_SGU_GROUPS, SGU_GROUP_DIM)
    causal = jnp.tril(jnp.ones((CHUNK, CHUNK), dtype=bool))
    ws = jnp.where(causal[None], w_s, 0).astype(v.dtype)
    mixed = jnp.einsum('gts,bnsgc->bntgc', ws, v) + b_s.T[None, None, :, :, None]
    out = u * mixed.reshape(B, S, GMLP_WIDTH)
    return out @ w_out + b_out


def hierarchical_moe(h, w_group_router, b_group_router, w_expert_router, b_expert_router,
                     w_gate_up, w_down):
    B, S, D = h.shape
    t = h.reshape(B * S, D)
    group_logits = (t @ w_group_router + b_group_router).astype(jnp.float32)
    group_probs = jax.nn.softmax(group_logits, axis=-1)
    g_p, g_idx = lax.top_k(group_probs, 1)
    group_onehot = jax.nn.one_hot(g_idx[:, 0], N_EXPERT_GROUPS, dtype=jnp.float32)
    expert_logits = (t @ w_expert_router + b_expert_router).astype(jnp.float32)
    expert_logits = expert_logits.reshape(-1, N_EXPERT_GROUPS, EXPERTS_PER_GROUP)
    sel_logits = jnp.sum(expert_logits * group_onehot[:, :, None], axis=1)
    top_vals, top_idx = lax.top_k(sel_logits, TOP_K_INNER)
    top_w = jax.nn.softmax(top_vals, axis=-1) * g_p
    inner = jnp.sum(jax.nn.one_hot(top_idx, EXPERTS_PER_GROUP, dtype=jnp.float32)
                    * top_w[..., None], axis=1)
    combine = (group_onehot[:, :, None] * inner[:, None, :]).astype(h.dtype)
    y = jnp.zeros_like(t)
    for g in range(N_EXPERT_GROUPS):
        gu = jnp.einsum('td,edf->tef', t, w_gate_up[g])
        gate, up = jnp.split(gu, 2, axis=-1)
        act = jax.nn.silu(gate) * up * combine[:, g, :, None]
        y = y + jnp.einsum('tef,efd->td', act, w_down[g])
    return y.reshape(B, S, D)


def setup_inputs(seed: int = 0) -> dict:
    key = jax.random.key(seed)
    ks = list(jax.random.split(key, 32))
    D = D_MODEL

    def nrm(i, shape, scale):
        return jax.random.normal(ks[i], shape, jnp.float32) * scale

    x = nrm(0, (BATCH, SEQ, D), 1.0)
    c = nrm(1, (BATCH, D), 1.0)
    positions = (jnp.arange(SEQ, dtype=jnp.int32)[None, :]
                 + jax.random.randint(ks[2], (BATCH, 1), 0, 4096, dtype=jnp.int32))
    ada_w = nrm(3, (DEPTH, D, N_MOD * D), 0.2 * D ** -0.5)
    ada_b = nrm(4, (DEPTH, N_MOD * D), 0.02)
    post_ln_g = 1.0 + nrm(5, (DEPTH, 2, D), 0.1)
    post_ln_b = nrm(6, (DEPTH, 2, D), 0.02)
    attn_w_qkv = nrm(7, (N_ATTN_LAYERS, D, QKV_WIDTH), D ** -0.5)
    attn_b_qkv = nrm(8, (N_ATTN_LAYERS, QKV_WIDTH), 0.02)
    attn_sinks = nrm(9, (N_ATTN_LAYERS, N_Q_HEADS), 1.0)
    attn_w_o = nrm(10, (N_ATTN_LAYERS, Q_WIDTH, D), Q_WIDTH ** -0.5 * DEEPNORM_BETA)
    attn_b_o = nrm(11, (N_ATTN_LAYERS, D), 0.02)
    gmlp_w_in = nrm(12, (N_GMLP_LAYERS, D, 2 * GMLP_WIDTH), D ** -0.5)
    gmlp_b_in = nrm(13, (N_GMLP_LAYERS, 2 * GMLP_WIDTH), 0.02)
    gmlp_sgu_ln_g = 1.0 + nrm(14, (N_GMLP_LAYERS, GMLP_WIDTH), 0.1)
    gmlp_sgu_ln_b = nrm(15, (N_GMLP_LAYERS, GMLP_WIDTH), 0.02)
    gmlp_w_s = nrm(16, (N_GMLP_LAYERS, N_SGU_GROUPS, CHUNK, CHUNK), CHUNK ** -0.5)
    gmlp_b_s = 1.0 + nrm(17, (N_GMLP_LAYERS, N_SGU_GROUPS, CHUNK), 0.1)
    gmlp_w_out = nrm(18, (N_GMLP_LAYERS, GMLP_WIDTH, D), GMLP_WIDTH ** -0.5 * DEEPNORM_BETA)
    gmlp_b_out = nrm(19, (N_GMLP_LAYERS, D), 0.02)
    moe_w_group_router = nrm(20, (DEPTH, D, N_EXPERT_GROUPS), D ** -0.5)
    moe_b_group_router = nrm(21, (DEPTH, N_EXPERT_GROUPS), 0.01)
    moe_w_expert_router = nrm(22, (DEPTH, D, N_EXPERT_GROUPS * EXPERTS_PER_GROUP), D ** -0.5)
    moe_b_expert_router = nrm(23, (DEPTH, N_EXPERT_GROUPS * EXPERTS_PER_GROUP), 0.01)
    moe_w_gate_up = nrm(24, (DEPTH, N_EXPERT_GROUPS, EXPERTS_PER_GROUP, D, 2 * EXPERT_FF), D ** -0.5)
    moe_w_down = nrm(25, (DEPTH, N_EXPERT_GROUPS, EXPERTS_PER_GROUP, EXPERT_FF, D),
                     EXPERT_FF ** -0.5 * DEEPNORM_BETA)
    return {"x": x, "c": c, "positions": positions, "ada_w": ada_w, "ada_b": ada_b,
            "post_ln_g": post_ln_g, "post_ln_b": post_ln_b,
            "attn_w_qkv": attn_w_qkv, "attn_b_qkv": attn_b_qkv, "attn_sinks": attn_sinks,
            "attn_w_o": attn_w_o, "attn_b_o": attn_b_o,
            "gmlp_w_in": gmlp_w_in, "gmlp_b_in": gmlp_b_in, "gmlp_sgu_ln_g": gmlp_sgu_ln_g,
            "gmlp_sgu_ln_b": gmlp_sgu_ln_b, "gmlp_w_s": gmlp_w_s, "gmlp_b_s": gmlp_b_s,
            "gmlp_w_out": gmlp_w_out, "gmlp_b_out": gmlp_b_out,
            "moe_w_group_router": moe_w_group_router, "moe_b_group_router": moe_b_group_router,
            "moe_w_expert_router": moe_w_expert_router, "moe_b_expert_router": moe_b_expert_router,
            "moe_w_gate_up": moe_w_gate_up, "moe_w_down": moe_w_down}


def reference(x, c, positions, ada_w, ada_b, post_ln_g, post_ln_b,
              attn_w_qkv, attn_b_qkv, attn_sinks, attn_w_o, attn_b_o,
              gmlp_w_in, gmlp_b_in, gmlp_sgu_ln_g, gmlp_sgu_ln_b, gmlp_w_s, gmlp_b_s,
              gmlp_w_out, gmlp_b_out,
              moe_w_group_router, moe_b_group_router, moe_w_expert_router, moe_b_expert_router,
              moe_w_gate_up, moe_w_down):
    inv_freq = ROPE_THETA ** (-jnp.arange(0, HEAD_DIM, 2, dtype=jnp.float32) / HEAD_DIM)
    ang = positions.astype(jnp.float32)[..., None] * inv_freq
    cos = jnp.cos(ang)[:, :, None, :]
    sin = jnp.sin(ang)[:, :, None, :]
    c_act = jax.nn.silu(c)
    for i in range(DEPTH):
        mod = (c_act @ ada_w[i] + ada_b[i])[:, None, :]
        sh_m, sc_m, gt_m, sh_f, sc_f, gt_f = jnp.split(mod, N_MOD, axis=-1)
        h = x * (1 + sc_m) + sh_m
        j = i // N_MIXERS
        if i % N_MIXERS == 0:
            y = sliding_window_sink_attention(h, cos, sin, attn_w_qkv[j], attn_b_qkv[j],
                                              attn_sinks[j], attn_w_o[j], attn_b_o[j])
        else:
            y = chunked_spatial_gating(h, gmlp_w_in[j], gmlp_b_in[j], gmlp_sgu_ln_g[j],
                                       gmlp_sgu_ln_b[j], gmlp_w_s[j], gmlp_b_s[j],
                                       gmlp_w_out[j], gmlp_b_out[j])
        x = layer_norm(DEEPNORM_ALPHA * x + (1 + gt_m) * y, post_ln_g[i, 0], post_ln_b[i, 0])
        h = x * (1 + sc_f) + sh_f
        y = hierarchical_moe(h, moe_w_group_router[i], moe_b_group_router[i],
                             moe_w_expert_router[i], moe_b_expert_router[i],
                             moe_w_gate_up[i], moe_w_down[i])
        x = layer_norm(DEEPNORM_ALPHA * x + (1 + gt_f) * y, post_ln_g[i, 1], post_ln_b[i, 1])
    return x
```

```cpp
#include <hip/hip_runtime.h>
#include <cstdio>
#include <cstdint>

typedef unsigned short bf16_t;
typedef unsigned u32x4 __attribute__((ext_vector_type(4)));
typedef unsigned u32x2 __attribute__((ext_vector_type(2)));
typedef float f32x4 __attribute__((ext_vector_type(4)));

constexpr int T = 16384, D = 1024, SEQ = 8192;
constexpr int NQKV = 1536, GW = 2048  , NEXP = 32, EFF = 256;
constexpr float LN_EPS = 1e-5f, ALPHA = 1.4142135623730951f;
constexpr float QSCALE = 0.125f * 1.4426950408889634f;
constexpr float LOG2E = 1.4426950408889634f;
constexpr int MAXTILES = 160, MPAD = MAXTILES * 256;

constexpr size_t MiB = 1u << 20;
constexpr size_t WS_CTL = 0;
constexpr size_t WS_MOD = 64 * 1024;
constexpr size_t WS_ROPE_C = 1 * MiB, WS_ROPE_S = 3 * MiB;
constexpr size_t WS_WS = 5 * MiB;
constexpr size_t WS_VSTAT = 6 * MiB;
constexpr size_t WS_LIST = 10 * MiB;
constexpr size_t WS_WL = 14 * MiB;
constexpr size_t WS_TAB = 18 * MiB;
constexpr size_t WS_ROWSTAT = 19 * MiB;
constexpr size_t WS_WQKV = 20 * MiB, WS_WO = 23 * MiB, WS_WIN = 25 * MiB, WS_WOUT = 33 * MiB, WS_WGU = 37 * MiB, WS_WD = 101 * MiB;
constexpr size_t WS_H = 133 * MiB, WS_X1 = 165 * MiB, WS_X2 = 229 * MiB, WS_RA = 293 * MiB, WS_END = 485 * MiB;
constexpr size_t RA_Q = 0, RA_K = 32 * MiB, RA_V = 40 * MiB, RA_O = 48 * MiB, RA_QKVRAW = 80 * MiB;
constexpr size_t RA_U = 0, RA_V2 = 64 * MiB, RA_GATED = 128 * MiB;
constexpr size_t RA_Y2 = 0, RA_ACT = 64 * MiB, RA_GURAW = 84 * MiB;

struct Params {
    const float* in[26];
    float* out;
    unsigned char* ws;
};
struct KA { Params p; const float* a; float* b; int i0, i1; };

__device__ __forceinline__ unsigned f2bf(float f) { unsigned u = __builtin_bit_cast(unsigned, f); return (u + 0x7fffu + ((u >> 16) & 1u)) >> 16; }
__device__ __forceinline__ unsigned pk2(float lo, float hi) { return f2bf(lo) | (f2bf(hi) << 16); }
__device__ __forceinline__ float bf2f(bf16_t v) { return __builtin_bit_cast(float, (unsigned)v << 16); }
__device__ __forceinline__ float wave_sum(float v) {
#pragma unroll
    for (int o = 1; o < 64; o <<= 1) v += __shfl_xor(v, o);
    return v;
}
__device__ __forceinline__ float wave_max(float v) {
#pragma unroll
    for (int o = 1; o < 64; o <<= 1) v = fmaxf(v, __shfl_xor(v, o));
    return v;
}
__device__ __forceinline__ float silu_f(float v) { return v / (1.f + expf(-v)); }

__device__ __forceinline__ int slot_qkv(int n) {
    int tile, hl, d;
    if (n < 1024) { const int head = n >> 6; d = n & 63; tile = head >> 2; hl = head & 3; }
    else if (n < 1280) { const int m = n - 1024; tile = 4; hl = m >> 6; d = m & 63; }
    else { const int m = n - 1280; tile = 5; hl = m >> 6; d = m & 63; }
    return tile * 256 + (d >> 5) * 128 + hl * 32 + (d & 31);
}
__device__ __forceinline__ int slot_gu(int n) {
    const int up = n >> 8, c = n & 255, pn = c >> 7; return pn * 256 + up * 128 + (c & 127);
}

__device__ __forceinline__ void mods_item(int item, const float* c, const float* ada_w, const float* ada_b, float* mod, float* lds) {
    const int tid = threadIdx.x, wave = tid >> 6, lane = tid & 63;
    const int l = item / 96, cg = item % 96;
    const float* W = ada_w + (size_t)l * 1024 * 6144 + cg * 64 + lane;
    float a0 = 0.f, a1 = 0.f;
    const int kb = wave * 128;
#pragma unroll 8
    for (int k = 0; k < 128; ++k) {
        const float w = W[(size_t)(kb + k) * 6144];
        a0 += silu_f(c[kb + k]) * w; a1 += silu_f(c[1024 + kb + k]) * w;
    }
    lds[(wave * 2 + 0) * 64 + lane] = a0; lds[(wave * 2 + 1) * 64 + lane] = a1;
    __syncthreads();
    if (tid < 128) { const int b = tid >> 6; float s = 0.f;
#pragma unroll
        for (int w = 0; w < 8; ++w) s += lds[(w * 2 + b) * 64 + lane];
        mod[(size_t)(l * 2 + b) * 6144 + cg * 64 + lane] = s + ada_b[l * 6144 + cg * 64 + lane]; }
    __syncthreads();
}
__device__ __forceinline__ void conv_item(const float* src, int K, int N, bf16_t* dst, int map, int item, int lane) {
    const int nblk = N >> 6, kb = item / nblk, nb = item % nblk, k0 = kb * 32, n = nb * 64 + lane;
    const float* s = src + (size_t)k0 * N + n;
    float v[32];
#pragma unroll
    for (int t = 0; t < 32; ++t) v[t] = s[(size_t)t * N];
    const int slot = map == 1 ? slot_qkv(n) : (map == 2 ? slot_gu(n) : n);
    u32x4* d = (u32x4*)(dst + (size_t)slot * K + k0);
#pragma unroll
    for (int j = 0; j < 4; ++j) { u32x4 o; o.x = pk2(v[8 * j], v[8 * j + 1]); o.y = pk2(v[8 * j + 2], v[8 * j + 3]); o.z = pk2(v[8 * j + 4], v[8 * j + 5]); o.w = pk2(v[8 * j + 6], v[8 * j + 7]); d[j] = o; }
}
constexpr int CI_QKV = 32 * 24, CI_WO = 32 * 16, CI_WIN = 32 * 64, CI_WOUT = 64 * 16, CI_GU1 = 32 * 8, CI_GU = 64 * CI_GU1, CI_DN1 = 8 * 16, CI_DN = 64 * CI_DN1;
constexpr int CI_TOTAL = CI_QKV + CI_WO + CI_WIN + CI_WOUT + CI_GU + CI_DN;

__device__ __forceinline__ void p0_prologue(const Params& p, int wg, int nwg, float* lds) {
    const int tid = threadIdx.x, wave = tid >> 6, lane = tid & 63;
    unsigned char* ws = p.ws;
    if (wg == 0 && tid < 128) ((int*)(ws + WS_CTL))[tid] = 0;
    for (int it = wg; it < 192; it += nwg) mods_item(it, p.in[1], p.in[3], p.in[4], (float*)(ws + WS_MOD), lds);
    const int gw = wg * 8 + wave, ngw = nwg * 8;
    for (int it = gw; it < CI_TOTAL; it += ngw) {
        int r = it;
        if (r < CI_QKV) { conv_item(p.in[7], 1024, 1536, (bf16_t*)(ws + WS_WQKV), 1, r, lane); continue; } r -= CI_QKV;
        if (r < CI_WO) { conv_item(p.in[10], 1024, 1024, (bf16_t*)(ws + WS_WO), 0, r, lane); continue; } r -= CI_WO;
        if (r < CI_WIN) { conv_item(p.in[12], 1024, 4096, (bf16_t*)(ws + WS_WIN), 0, r, lane); continue; } r -= CI_WIN;
        if (r < CI_WOUT) { conv_item(p.in[18], 2048, 1024, (bf16_t*)(ws + WS_WOUT), 0, r, lane); continue; } r -= CI_WOUT;
        if (r < CI_GU) { const int mtx = r / CI_GU1; conv_item(p.in[24] + (size_t)mtx * 1024 * 512, 1024, 512, (bf16_t*)(ws + WS_WGU) + (size_t)mtx * 512 * 1024, 2, r % CI_GU1, lane); continue; } r -= CI_GU;
        { const int mtx = r / CI_DN1; conv_item(p.in[25] + (size_t)mtx * 256 * 1024, 256, 1024, (bf16_t*)(ws + WS_WD) + (size_t)mtx * 1024 * 256, 0, r % CI_DN1, lane); }
    }
    const int gt = wg * 512 + tid, ngt = nwg * 512;
    for (int i = gt; i < 8 * 128 * 128; i += ngt) { const int t = (i >> 7) & 127, s = i & 127; ((bf16_t*)(ws + WS_WS))[i] = (bf16_t)f2bf(s <= t ? p.in[16][i] : 0.f); }
    const int* pos = (const int*)p.in[2];
    for (int i = gt; i < T * 32; i += ngt) {
        const int row = i >> 5, j = i & 31;
        double f = 1.0;
        for (int q = 0; q < j; ++q) f *= 0.7498942093324558;
        const double rev = (double)pos[row] * f * 0.15915494309189535;
        const float fr = (float)(rev - floor(rev));
        ((float*)(ws + WS_ROPE_C))[i] = __builtin_amdgcn_cosf(fr);
        ((float*)(ws + WS_ROPE_S))[i] = __builtin_amdgcn_sinf(fr);
    }
}

__device__ __forceinline__ void phase_h0(const Params& p, int gw, int ngw, int lane) {
    const float* x = p.in[0]; const float* mod = (const float*)(p.ws + WS_MOD); bf16_t* H = (bf16_t*)(p.ws + WS_H);
    for (int row = gw; row < T; row += ngw) {
        const int b = row >> 13; const float* sh = mod + (size_t)(0 * 2 + b) * 6144; const float* sc = sh + 1024;
#pragma unroll
        for (int j = 0; j < 4; ++j) { const int col = 4 * lane + 256 * j;
            const f32x4 xv = *(const f32x4*)(x + (size_t)row * D + col), s = *(const f32x4*)(sc + col), h = *(const f32x4*)(sh + col);
            const f32x4 o = xv * (s + 1.0f) + h; u32x2 w; w.x = pk2(o.x, o.y); w.y = pk2(o.z, o.w); *(u32x2*)(H + (size_t)row * D + col) = w; }
    }
}
__device__ __forceinline__ void phase_ln_router(const Params& p, int l, const float* z, float* xo, int wg, int nwg, float* lds) {
    const int tid = threadIdx.x, wave = tid >> 6, lane = tid & 63;
    const float* wgr = p.in[20] + (size_t)l * 1024 * 4; const float* bgr = p.in[21] + l * 4;
    const float* wer = p.in[22] + (size_t)l * 1024 * 32; const float* ber = p.in[23] + l * 32;
    for (int o = 0; o < 36; ++o)
        for (int k = tid; k < 1024; k += 512) lds[o * 1024 + k] = o < 4 ? wgr[k * 4 + o] : wer[k * 32 + (o - 4)];
    __syncthreads();
    const float* lg = p.in[5] + (size_t)(l * 2 + 0) * D; const float* lb = p.in[6] + (size_t)(l * 2 + 0) * D;
    const float* mod = (const float*)(p.ws + WS_MOD); bf16_t* H = (bf16_t*)(p.ws + WS_H);
    int* cnt = (int*)(p.ws + WS_CTL) + l * 32; int* list = (int*)(p.ws + WS_LIST) + (size_t)l * 32 * T; float* wl = (float*)(p.ws + WS_WL) + (size_t)l * 32 * T;
    const int gw = wg * 8 + wave, ngw = nwg * 8;
    for (int row = gw; row < T; row += ngw) {
        const int b = row >> 13; const float* sh = mod + (size_t)(l * 2 + b) * 6144 + 3 * 1024; const float* sc = sh + 1024;
        f32x4 v[4]; float s = 0.f;
#pragma unroll
        for (int j = 0; j < 4; ++j) { v[j] = *(const f32x4*)(z + (size_t)row * D + 4 * lane + 256 * j); s += (v[j].x + v[j].y) + (v[j].z + v[j].w); }
        const float mean = wave_sum(s) * (1.f / D); float s2 = 0.f;
#pragma unroll
        for (int j = 0; j < 4; ++j) { v[j] = v[j] - mean; s2 += (v[j].x * v[j].x + v[j].y * v[j].y) + (v[j].z * v[j].z + v[j].w * v[j].w); }
        const float rstd = 1.f / sqrtf(wave_sum(s2) * (1.f / D) + LN_EPS);
        f32x4 h[4];
#pragma unroll
        for (int j = 0; j < 4; ++j) { const int col = 4 * lane + 256 * j;
            const f32x4 x1 = v[j] * rstd * *(const f32x4*)(lg + col) + *(const f32x4*)(lb + col);
            *(f32x4*)(xo + (size_t)row * D + col) = x1;
            h[j] = x1 * (*(const f32x4*)(sc + col) + 1.0f) + *(const f32x4*)(sh + col);
            u32x2 w; w.x = pk2(h[j].x, h[j].y); w.y = pk2(h[j].z, h[j].w); *(u32x2*)(H + (size_t)row * D + col) = w; }
        float gl[4];
#pragma unroll
        for (int o = 0; o < 4; ++o) { float a = 0.f;
#pragma unroll
            for (int j = 0; j < 4; ++j) { const f32x4 w = *(const f32x4*)(lds + o * 1024 + 4 * lane + 256 * j); a += (h[j].x * w.x + h[j].y * w.y) + (h[j].z * w.z + h[j].w * w.w); }
            gl[o] = wave_sum(a) + bgr[o]; }
        int g = 0; float gm = gl[0];
#pragma unroll
        for (int o = 1; o < 4; ++o) if (gl[o] > gm) { gm = gl[o]; g = o; }
        float gs = 0.f;
#pragma unroll
        for (int o = 0; o < 4; ++o) gs += expf(gl[o] - gm);
        const float gp = 1.f / gs;
        g = __builtin_amdgcn_readfirstlane(g);
        float el[8];
#pragma unroll
        for (int e = 0; e < 8; ++e) { float a = 0.f; const float* wrow = lds + (4 + g * 8 + e) * 1024;
#pragma unroll
            for (int j = 0; j < 4; ++j) { const f32x4 w = *(const f32x4*)(wrow + 4 * lane + 256 * j); a += (h[j].x * w.x + h[j].y * w.y) + (h[j].z * w.z + h[j].w * w.w); }
            el[e] = wave_sum(a) + ber[g * 8 + e]; }
        int e0 = 0; float v0 = el[0];
#pragma unroll
        for (int e = 1; e < 8; ++e) if (el[e] > v0) { v0 = el[e]; e0 = e; }
        int e1 = -1; float v1 = -INFINITY;
#pragma unroll
        for (int e = 0; e < 8; ++e) if (e != e0 && el[e] > v1) { v1 = el[e]; e1 = e; }
        const float w0 = 1.f / (1.f + expf(v1 - v0)), w1 = 1.f - w0;
        if (lane == 0) {
            const int ea = g * 8 + e0, eb = g * 8 + e1;
            const int pa = atomicAdd(cnt + ea, 1); list[(size_t)ea * T + pa] = row * 2 + 0; wl[(size_t)ea * T + pa] = w0 * gp;
            const int pb = atomicAdd(cnt + eb, 1); list[(size_t)eb * T + pb] = row * 2 + 1; wl[(size_t)eb * T + pb] = w1 * gp;
        }
    }
}
__device__ __forceinline__ void phase_ln2(const Params& p, int l, const float* x1, float* xo, int nextl, int gw, int ngw, int lane) {
    const float* lg = p.in[5] + (size_t)(l * 2 + 1) * D; const float* lb = p.in[6] + (size_t)(l * 2 + 1) * D;
    const float* mod = (const float*)(p.ws + WS_MOD); bf16_t* H = (bf16_t*)(p.ws + WS_H); const bf16_t* y2 = (const bf16_t*)(p.ws + WS_RA + RA_Y2);
    for (int row = gw; row < T; row += ngw) {
        const int b = row >> 13; const float* gt = mod + (size_t)(l * 2 + b) * 6144 + 5 * 1024;
        f32x4 v[4]; float s = 0.f;
#pragma unroll
        for (int j = 0; j < 4; ++j) { const int col = 4 * lane + 256 * j;
            const f32x4 xv = *(const f32x4*)(x1 + (size_t)row * D + col), g = *(const f32x4*)(gt + col);
            const u32x2 ya = *(const u32x2*)(y2 + ((size_t)row * 2 + 0) * D + col), yb = *(const u32x2*)(y2 + ((size_t)row * 2 + 1) * D + col);
            f32x4 y; y.x = __builtin_bit_cast(float, ya.x << 16) + __builtin_bit_cast(float, yb.x << 16); y.y = __builtin_bit_cast(float, ya.x & 0xffff0000u) + __builtin_bit_cast(float, yb.x & 0xffff0000u);
            y.z = __builtin_bit_cast(float, ya.y << 16) + __builtin_bit_cast(float, yb.y << 16); y.w = __builtin_bit_cast(float, ya.y & 0xffff0000u) + __builtin_bit_cast(float, yb.y & 0xffff0000u);
            v[j] = xv * ALPHA + (g + 1.0f) * y; s += (v[j].x + v[j].y) + (v[j].z + v[j].w); }
        const float mean = wave_sum(s) * (1.f / D); float s2 = 0.f;
#pragma unroll
        for (int j = 0; j < 4; ++j) { v[j] = v[j] - mean; s2 += (v[j].x * v[j].x + v[j].y * v[j].y) + (v[j].z * v[j].z + v[j].w * v[j].w); }
        const float rstd = 1.f / sqrtf(wave_sum(s2) * (1.f / D) + LN_EPS);
        const float* sh = mod + (size_t)((nextl < 0 ? 0 : nextl) * 2 + b) * 6144; const float* sc = sh + 1024;
#pragma unroll
        for (int j = 0; j < 4; ++j) { const int col = 4 * lane + 256 * j;
            const f32x4 x2 = v[j] * rstd * *(const f32x4*)(lg + col) + *(const f32x4*)(lb + col);
            *(f32x4*)(xo + (size_t)row * D + col) = x2;
            if (nextl >= 0) { const f32x4 h = x2 * (*(const f32x4*)(sc + col) + 1.0f) + *(const f32x4*)(sh + col);
                u32x2 w; w.x = pk2(h.x, h.y); w.y = pk2(h.z, h.w); *(u32x2*)(H + (size_t)row * D + col) = w; } }
    }
}

__global__ void __launch_bounds__(512) k_prologue(Params p) { __shared__ float lds[1024]; p0_prologue(p, blockIdx.x, gridDim.x, lds); }
__global__ void __launch_bounds__(512) k_h0(Params p) { phase_h0(p, blockIdx.x * 8 + (threadIdx.x >> 6), gridDim.x * 8, threadIdx.x & 63); }
__global__ void __launch_bounds__(512) k_ln_router(KA a) { extern __shared__ float dl[]; phase_ln_router(a.p, a.i0, a.a, a.b, blockIdx.x, gridDim.x, dl); }
__global__ void __launch_bounds__(512) k_ln2(KA a) { phase_ln2(a.p, a.i0, a.a, a.b, a.i1, blockIdx.x * 8 + (threadIdx.x >> 6), gridDim.x * 8, threadIdx.x & 63); }

struct NG { const bf16_t* A; const int* rowmap; const bf16_t* Bt; const int* tile_expert; const int* ntiles; size_t estride; int lda, ldb, K, pad; };
template <class Epi> __global__ void __launch_bounds__(256) ngemm(NG g, Epi E) {
    __shared__ float As[16][68], Bs[16][68];
    const int tid = threadIdx.x, tx = tid & 15, ty = tid >> 4;
    const int m0 = blockIdx.y * 64, n0 = blockIdx.x * 64;
    const bf16_t* Bt = g.Bt;
    if (g.tile_expert) { if ((m0 >> 8) >= *g.ntiles) return; Bt += (size_t)g.tile_expert[m0 >> 8] * g.estride; }
    const int lr = tid >> 2, kq = tid & 3;
    int arow = m0 + lr; if (g.rowmap) { const int rm = g.rowmap[arow]; arow = rm < 0 ? 0 : (rm >> 1); }
    const bf16_t* ap = g.A + (size_t)arow * g.lda + kq * 4; const bf16_t* bp = Bt + (size_t)(n0 + lr) * g.ldb + kq * 4;
    float acc[4][4];
#pragma unroll
    for (int i = 0; i < 4; ++i)
#pragma unroll
        for (int j = 0; j < 4; ++j) acc[i][j] = 0.f;
    for (int k0 = 0; k0 < g.K; k0 += 16) {
        const u32x2 av = *(const u32x2*)(ap + k0), bv = *(const u32x2*)(bp + k0);
        __syncthreads();
        As[kq * 4 + 0][lr] = __builtin_bit_cast(float, av.x << 16); As[kq * 4 + 1][lr] = __builtin_bit_cast(float, av.x & 0xffff0000u);
        As[kq * 4 + 2][lr] = __builtin_bit_cast(float, av.y << 16); As[kq * 4 + 3][lr] = __builtin_bit_cast(float, av.y & 0xffff0000u);
        Bs[kq * 4 + 0][lr] = __builtin_bit_cast(float, bv.x << 16); Bs[kq * 4 + 1][lr] = __builtin_bit_cast(float, bv.x & 0xffff0000u);
        Bs[kq * 4 + 2][lr] = __builtin_bit_cast(float, bv.y << 16); Bs[kq * 4 + 3][lr] = __builtin_bit_cast(float, bv.y & 0xffff0000u);
        __syncthreads();
#pragma unroll
        for (int k = 0; k < 16; ++k) {
            const f32x4 a = *(const f32x4*)&As[k][ty * 4], b = *(const f32x4*)&Bs[k][tx * 4];
#pragma unroll
            for (int i = 0; i < 4; ++i)
#pragma unroll
                for (int j = 0; j < 4; ++j) acc[i][j] += a[i] * b[j];
        }
    }
#pragma unroll
    for (int i = 0; i < 4; ++i)
#pragma unroll
        for (int j = 0; j < 4; ++j) E(m0 + ty * 4 + i, n0 + tx * 4 + j, acc[i][j]);
}
struct NEpiF32 { float* C; int ldc, pad; __device__ void operator()(int r, int c, float v) const { C[(size_t)r * ldc + c] = v; } };
struct NEpiResid { const float* x; const float* bias; const float* gt  ; float* z;
    __device__ void operator()(int r, int c, float v) const { const int b = r >> 13; z[(size_t)r * D + c] = ALPHA * x[(size_t)r * D + c] + (1.f + gt[b * 6144 + c]) * (v + bias[c]); } };
struct NEpiGelu { const float* bias; bf16_t* U; bf16_t* V;
    __device__ void operator()(int r, int c, float v) const { const float a = v + bias[c]; const float g = 0.5f * a * (1.f + erff(a * 0.70710678118654752f));
        if (c < GW) U[(size_t)r * GW + c] = (bf16_t)f2bf(g); else V[(size_t)r * GW + c - GW] = (bf16_t)f2bf(g); } };
struct NEpiMoe2 { const int* rowmap; bf16_t* y2; __device__ void operator()(int r, int c, float v) const { const int rm = rowmap[r]; if (rm >= 0) y2[(size_t)rm * D + c] = (bf16_t)f2bf(v); } };

__global__ void k_rope_post(Params p) {
    const size_t i = (size_t)blockIdx.x * 256 + threadIdx.x; if (i >= (size_t)T * 768) return;
    const int row = (int)(i / 768), q = (int)(i % 768);
    const int tile = q / 128, hl = (q % 128) / 32, dp = q % 32;
    const float* raw = (const float*)(p.ws + WS_RA + RA_QKVRAW) + (size_t)row * NQKV + tile * 256;
    const float* bq = p.in[8];
    int scol; bf16_t* dst; float sc = 1.f; int ld;
    if (tile < 4) { scol = (tile * 4 + hl) * 64; dst = (bf16_t*)(p.ws + WS_RA + RA_Q) + (size_t)row * 1024 + scol; sc = QSCALE; }
    else if (tile == 4) { scol = 1024 + hl * 64; dst = (bf16_t*)(p.ws + WS_RA + RA_K) + (size_t)row * 256 + hl * 64; }
    else { scol = 1280 + hl * 64; dst = (bf16_t*)(p.ws + WS_RA + RA_V) + (size_t)row * 256 + hl * 64; }
    const float x1 = raw[hl * 32 + dp] + bq[scol + dp], x2 = raw[128 + hl * 32 + dp] + bq[scol + 32 + dp];
    float o1 = x1, o2 = x2;
    if (tile < 5) { const float cs = ((const float*)(p.ws + WS_ROPE_C))[(size_t)row * 32 + dp], sn = ((const float*)(p.ws + WS_ROPE_S))[(size_t)row * 32 + dp];
        o1 = x1 * cs - x2 * sn; o2 = x2 * cs + x1 * sn; }
    dst[dp] = (bf16_t)f2bf(o1 * sc); dst[32 + dp] = (bf16_t)f2bf(o2 * sc);
    (void)ld;
}
__global__ void __launch_bounds__(256) k_attn_naive(Params p) {
    const int w = blockIdx.x * 4 + (threadIdx.x >> 6), lane = threadIdx.x & 63;
    const int row = w >> 4, hq = w & 15, kvh = hq >> 2, s = row & (SEQ - 1);
    const bf16_t* Q = (const bf16_t*)(p.ws + WS_RA + RA_Q) + (size_t)row * 1024 + hq * 64;
    const bf16_t* Kb = (const bf16_t*)(p.ws + WS_RA + RA_K); const bf16_t* Vb = (const bf16_t*)(p.ws + WS_RA + RA_V);
    float q[64];
#pragma unroll
    for (int i = 0; i < 8; ++i) { const u32x4 v = *(const u32x4*)(Q + i * 8);
        q[8 * i] = __builtin_bit_cast(float, v.x << 16); q[8 * i + 1] = __builtin_bit_cast(float, v.x & 0xffff0000u); q[8 * i + 2] = __builtin_bit_cast(float, v.y << 16); q[8 * i + 3] = __builtin_bit_cast(float, v.y & 0xffff0000u);
        q[8 * i + 4] = __builtin_bit_cast(float, v.z << 16); q[8 * i + 5] = __builtin_bit_cast(float, v.z & 0xffff0000u); q[8 * i + 6] = __builtin_bit_cast(float, v.w << 16); q[8 * i + 7] = __builtin_bit_cast(float, v.w & 0xffff0000u); }
    float sc[2];
#pragma unroll
    for (int h = 0; h < 2; ++h) { const int ks = s - 127 + h * 64 + lane; float a = -INFINITY;
        if (ks >= 0) { const bf16_t* kr = Kb + (size_t)(row - s + ks) * 256 + kvh * 64; a = 0.f;
#pragma unroll
            for (int i = 0; i < 8; ++i) { const u32x4 v = *(const u32x4*)(kr + i * 8);
                a += q[8 * i] * __builtin_bit_cast(float, v.x << 16) + q[8 * i + 1] * __builtin_bit_cast(float, v.x & 0xffff0000u) + q[8 * i + 2] * __builtin_bit_cast(float, v.y << 16) + q[8 * i + 3] * __builtin_bit_cast(float, v.y & 0xffff0000u)
                   + q[8 * i + 4] * __builtin_bit_cast(float, v.z << 16) + q[8 * i + 5] * __builtin_bit_cast(float, v.z & 0xffff0000u) + q[8 * i + 6] * __builtin_bit_cast(float, v.w << 16) + q[8 * i + 7] * __builtin_bit_cast(float, v.w & 0xffff0000u); } }
        sc[h] = a; }
    const float sink = p.in[9][hq] * LOG2E;
    const float m = fmaxf(wave_max(fmaxf(sc[0], sc[1])), sink);
    const float p0 = exp2f(sc[0] - m), p1 = exp2f(sc[1] - m);
    const float den = wave_sum(p0 + p1) + exp2f(sink - m);
    float o = 0.f;
    for (int j = 0; j < 64; ++j) {
        const float a0 = __shfl(p0, j), a1 = __shfl(p1, j);
        const int k0 = s - 127 + j, k1 = s - 63 + j;
        if (k0 >= 0) o += a0 * bf2f(Vb[(size_t)(row - s + k0) * 256 + kvh * 64 + lane]);
        if (k1 >= 0) o += a1 * bf2f(Vb[(size_t)(row - s + k1) * 256 + kvh * 64 + lane]);
    }
    ((bf16_t*)(p.ws + WS_RA + RA_O))[(size_t)row * 1024 + hq * 64 + lane] = (bf16_t)f2bf(o / den);
}
__global__ void __launch_bounds__(256) k_vstat_naive(Params p) {
    const int row = blockIdx.x * 4 + (threadIdx.x >> 6), lane = threadIdx.x & 63;
    const bf16_t* v = (const bf16_t*)(p.ws + WS_RA + RA_V2) + (size_t)row * GW;
    float s = 0.f, s2 = 0.f;
    for (int i = lane; i < GW; i += 64) { const float a = bf2f(v[i]); s += a; s2 += a * a; }
    s = wave_sum(s); s2 = wave_sum(s2);
    const float mean = s * (1.f / GW), var = fmaxf(s2 * (1.f / GW) - mean * mean, 0.f);
    if (lane == 0) { float* rs = (float*)(p.ws + WS_ROWSTAT) + (size_t)row * 2; rs[0] = mean; rs[1] = 1.f / sqrtf(var + LN_EPS); }
}
__global__ void __launch_bounds__(256) k_gate_naive(Params p) {
    const size_t i = (size_t)blockIdx.x * 256 + threadIdx.x;
    const int t = (int)(i >> 11), c = (int)(i & 2047), tt = t & 127, t0 = t - tt, g = c >> 8;
    const bf16_t* v = (const bf16_t*)(p.ws + WS_RA + RA_V2); const bf16_t* u = (const bf16_t*)(p.ws + WS_RA + RA_U);
    const bf16_t* w = (const bf16_t*)(p.ws + WS_WS) + (size_t)(g * 128 + tt) * 128; const float* rs = (const float*)(p.ws + WS_ROWSTAT);
    const float lg = p.in[14][c], lb = p.in[15][c];
    float a = 0.f;
    for (int s = 0; s <= tt; ++s) { const float vn = (bf2f(v[(size_t)(t0 + s) * GW + c]) - rs[(size_t)(t0 + s) * 2]) * rs[(size_t)(t0 + s) * 2 + 1] * lg + lb; a += bf2f(w[s]) * vn; }
    a += p.in[17][g * 128 + tt];
    ((bf16_t*)(p.ws + WS_RA + RA_GATED))[i] = (bf16_t)f2bf(bf2f(u[i]) * a);
}
__global__ void __launch_bounds__(256) k_moe_prep(KA ka) {
    const Params& p = ka.p; const int l = ka.i0;
    __shared__ int tb[33];
    const int* cnt = (const int*)(p.ws + WS_CTL) + l * 32; const int* list = (const int*)(p.ws + WS_LIST) + (size_t)l * 32 * T; const float* wl = (const float*)(p.ws + WS_WL) + (size_t)l * 32 * T;
    int* rowmap = (int*)(p.ws + WS_TAB); float* wrow = (float*)(p.ws + WS_TAB) + MPAD; int* te = (int*)(p.ws + WS_TAB) + 2 * MPAD; int* nt = (int*)(p.ws + WS_CTL) + 64 + l;
    if (threadIdx.x == 0) { int a = 0; for (int e = 0; e < 32; ++e) { tb[e] = a; a += (cnt[e] + 255) >> 8; } tb[32] = a; *nt = a; }
    __syncthreads();
    for (int e = 0; e < 32; ++e) {
        const int n = cnt[e];
        for (int tl = tb[e]; tl < tb[e + 1]; ++tl) { if (threadIdx.x == 0) te[tl] = e;
            const int idx = (tl - tb[e]) * 256 + threadIdx.x; rowmap[tl * 256 + threadIdx.x] = idx < n ? list[(size_t)e * T + idx] : -1; wrow[tl * 256 + threadIdx.x] = idx < n ? wl[(size_t)e * T + idx] : 0.f; }
    }
}
__global__ void __launch_bounds__(256) k_moe1_post(KA ka) {
    const Params& p = ka.p; const int l = ka.i0;
    const size_t i = (size_t)blockIdx.x * 256 + threadIdx.x; const int m = (int)(i >> 8), c = (int)(i & 255);
    const int nt = ((const int*)(p.ws + WS_CTL))[64 + l]; if (m >= nt * 256) return;
    const float* gu = (const float*)(p.ws + WS_RA + RA_GURAW) + (size_t)m * 512; const float w = ((const float*)(p.ws + WS_TAB))[MPAD + m];
    const int pn = c >> 7, j = c & 127; const float g = gu[pn * 256 + j], u = gu[pn * 256 + 128 + j];
    ((bf16_t*)(p.ws + WS_RA + RA_ACT))[i] = (bf16_t)f2bf(silu_f(g) * u * w);
}

extern "C" void kernel_launch(void* const* d_in, const int* in_sizes, int n_in, void* d_out, int out_size, void* d_ws, size_t ws_size, hipStream_t stream) {
    if (n_in != 26 || out_size != T * D || ws_size < WS_END) { fprintf(stderr, "kernel_launch: unexpected problem (n_in %d out %d ws %zu)\n", n_in, out_size, ws_size); return; }
    static bool attr = false;
    if (!attr) { (void)hipFuncSetAttribute((const void*)k_ln_router, hipFuncAttributeMaxDynamicSharedMemorySize, 36 * 1024 * 4); attr = true; }
    Params p{};
    for (int i = 0; i < 26; ++i) p.in[i] = (const float*)d_in[i];
    p.out = (float*)d_out; p.ws = (unsigned char*)d_ws;
    unsigned char* ws = p.ws;
    float* Z = p.out; float* X1 = (float*)(ws + WS_X1); float* X2 = (float*)(ws + WS_X2); const float* mod = (const float*)(ws + WS_MOD);
    bf16_t* H = (bf16_t*)(ws + WS_H);
    const int* rowmap = (const int*)(ws + WS_TAB); const int* te = (const int*)(ws + WS_TAB) + 2 * MPAD;
    hipLaunchKernelGGL(k_prologue, dim3(256), dim3(512), 0, stream, p);
    hipLaunchKernelGGL(k_h0, dim3(256), dim3(512), 0, stream, p);
    for (int l = 0; l < 2; ++l) {
        if (l == 0) {
            NG g{H, nullptr, (const bf16_t*)(ws + WS_WQKV), nullptr, nullptr, 0, D, D, D, 0};
            hipLaunchKernelGGL(ngemm<NEpiF32>, dim3(NQKV / 64, T / 64), dim3(256), 0, stream, g, NEpiF32{(float*)(ws + WS_RA + RA_QKVRAW), NQKV, 0});
            hipLaunchKernelGGL(k_rope_post, dim3(T * 768 / 256), dim3(256), 0, stream, p);
            hipLaunchKernelGGL(k_attn_naive, dim3(T * 16 / 4), dim3(256), 0, stream, p);
            NG g2{(const bf16_t*)(ws + WS_RA + RA_O), nullptr, (const bf16_t*)(ws + WS_WO), nullptr, nullptr, 0, D, D, D, 0};
            hipLaunchKernelGGL(ngemm<NEpiResid>, dim3(D / 64, T / 64), dim3(256), 0, stream, g2, NEpiResid{p.in[0], p.in[11], mod + 2 * 1024, Z});
        } else {
            NG g{H, nullptr, (const bf16_t*)(ws + WS_WIN), nullptr, nullptr, 0, D, D, D, 0};
            hipLaunchKernelGGL(ngemm<NEpiGelu>, dim3(4096 / 64, T / 64), dim3(256), 0, stream, g, NEpiGelu{p.in[13], (bf16_t*)(ws + WS_RA + RA_U), (bf16_t*)(ws + WS_RA + RA_V2)});
            hipLaunchKernelGGL(k_vstat_naive, dim3(T / 4), dim3(256), 0, stream, p);
            hipLaunchKernelGGL(k_gate_naive, dim3(T * GW / 256), dim3(256), 0, stream, p);
            NG g2{(const bf16_t*)(ws + WS_RA + RA_GATED), nullptr, (const bf16_t*)(ws + WS_WOUT), nullptr, nullptr, 0, GW, GW, GW, 0};
            hipLaunchKernelGGL(ngemm<NEpiResid>, dim3(D / 64, T / 64), dim3(256), 0, stream, g2, NEpiResid{X2, p.in[19], mod + 2 * 6144 + 2 * 1024, Z});
        }
        hipLaunchKernelGGL(k_ln_router, dim3(256), dim3(512), 36 * 1024 * 4, stream, KA{p, (const float*)Z, X1, l, 0});
        hipLaunchKernelGGL(k_moe_prep, dim3(1), dim3(256), 0, stream, KA{p, nullptr, nullptr, l, 0});
        const int* nt = (const int*)(ws + WS_CTL) + 64 + l;
        NG g3{H, rowmap, (const bf16_t*)(ws + WS_WGU) + (size_t)l * 32 * 512 * 1024, te, nt, (size_t)512 * 1024, D, D, D, 0};
        hipLaunchKernelGGL(ngemm<NEpiF32>, dim3(512 / 64, MPAD / 64), dim3(256), 0, stream, g3, NEpiF32{(float*)(ws + WS_RA + RA_GURAW), 512, 0});
        hipLaunchKernelGGL(k_moe1_post, dim3(MPAD), dim3(256), 0, stream, KA{p, nullptr, nullptr, l, 0});
        NG g4{(const bf16_t*)(ws + WS_RA + RA_ACT), nullptr, (const bf16_t*)(ws + WS_WD) + (size_t)l * 32 * 1024 * 256, te, nt, (size_t)1024 * 256, EFF, EFF, EFF, 0};
        hipLaunchKernelGGL(ngemm<NEpiMoe2>, dim3(D / 64, MPAD / 64), dim3(256), 0, stream, g4, NEpiMoe2{rowmap, (bf16_t*)(ws + WS_RA + RA_Y2)});
        hipLaunchKernelGGL(k_ln2, dim3(256), dim3(512), 0, stream, KA{p, (const float*)X1, l == 0 ? X2 : p.out, l, l == 0 ? 1 : -1});
    }
}
```

```cpp
#include <hip/hip_runtime.h>
#include <hip/hip_cooperative_groups.h>
#include <cstdio>
#include <cstdint>

typedef unsigned short bf16_t;
typedef unsigned u32x4 __attribute__((ext_vector_type(4)));
typedef unsigned u32x2 __attribute__((ext_vector_type(2)));
typedef float f32x4 __attribute__((ext_vector_type(4)));
typedef float f32x2v __attribute__((ext_vector_type(2)));

constexpr int T = 16384, D = 1024, SEQ = 8192;
constexpr int NQKV = 1536, GW = 2048  , NEXP = 32, EFF = 256;
constexpr float LN_EPS = 1e-5f, ALPHA = 1.4142135623730951f;
constexpr float QSCALE = 0.125f * 1.4426950408889634f;
constexpr float LOG2E = 1.4426950408889634f;
constexpr int MAXTILES = 160, MPAD = MAXTILES * 256;

constexpr size_t MiB = 1u << 20;
constexpr size_t WS_CTL = 0;
constexpr size_t WS_MOD = 64 * 1024;
constexpr size_t WS_ROPE_C = 1 * MiB, WS_ROPE_S = 3 * MiB;
constexpr size_t WS_WS = 5 * MiB;
constexpr size_t WS_VSTAT = 6 * MiB;
constexpr size_t WS_LIST = 10 * MiB;
constexpr size_t WS_WL = 14 * MiB;
constexpr size_t WS_TAB = 18 * MiB;
constexpr size_t WS_ROWSTAT = 19 * MiB;
constexpr size_t WS_WQKV = 20 * MiB, WS_WO = 23 * MiB, WS_WIN = 25 * MiB, WS_WOUT = 33 * MiB, WS_WGU = 37 * MiB, WS_WD = 101 * MiB;
constexpr size_t WS_H = 133 * MiB, WS_X1 = 165 * MiB, WS_X2 = 229 * MiB, WS_RA = 293 * MiB, WS_END = 485 * MiB;
constexpr size_t RA_Q = 0, RA_K = 32 * MiB, RA_V = 40 * MiB, RA_O = 48 * MiB, RA_QKVRAW = 80 * MiB;
constexpr size_t RA_U = 0, RA_V2 = 64 * MiB, RA_GATED = 128 * MiB;
constexpr size_t RA_Y2 = 0, RA_ACT = 64 * MiB, RA_GURAW = 84 * MiB;

struct Params {
    const float* in[26];
    float* out;
    unsigned char* ws;
};
struct KA { Params p; const float* a; float* b; int i0, i1; };

__device__ __forceinline__ unsigned f2bf(float f) { unsigned u = __builtin_bit_cast(unsigned, f); return (u + 0x7fffu + ((u >> 16) & 1u)) >> 16; }
__device__ __forceinline__ unsigned pk2(float lo, float hi) { return f2bf(lo) | (f2bf(hi) << 16); }
__device__ __forceinline__ float bf2f(bf16_t v) { return __builtin_bit_cast(float, (unsigned)v << 16); }
__device__ __forceinline__ float wave_sum(float v) {
#pragma unroll
    for (int o = 1; o < 64; o <<= 1) v += __shfl_xor(v, o);
    return v;
}
__device__ __forceinline__ float wave_max(float v) {
#pragma unroll
    for (int o = 1; o < 64; o <<= 1) v = fmaxf(v, __shfl_xor(v, o));
    return v;
}
__device__ __forceinline__ float silu_f(float v) { return v / (1.f + expf(-v)); }

__device__ __forceinline__ int slot_qkv(int n) {
    int tile, hl, d;
    if (n < 1024) { const int head = n >> 6; d = n & 63; tile = head >> 2; hl = head & 3; }
    else if (n < 1280) { const int m = n - 1024; tile = 4; hl = m >> 6; d = m & 63; }
    else { const int m = n - 1280; tile = 5; hl = m >> 6; d = m & 63; }
    return tile * 256 + (d >> 5) * 128 + hl * 32 + (d & 31);
}
__device__ __forceinline__ int slot_gu(int n) {
    const int up = n >> 8, c = n & 255, pn = c >> 7; return pn * 256 + up * 128 + (c & 127);
}

__device__ __forceinline__ int fresh_tid() { int t = threadIdx.x; asm volatile("" : "+v"(t)); return t; }

__device__ __forceinline__ void mods_item(int tid, int item, const float* c, const float* ada_w, const float* ada_b, float* mod, float* lds) {
    const int wave = tid >> 6, lane = tid & 63;
    const int l = item / 96, cg = item % 96;
    const float* W = ada_w + (size_t)l * 1024 * 6144 + cg * 64 + lane;
    float a0 = 0.f, a1 = 0.f;
    const int kb = wave * 128;
#pragma unroll 8
    for (int k = 0; k < 128; ++k) {
        const float w = W[(size_t)(kb + k) * 6144];
        a0 += silu_f(c[kb + k]) * w; a1 += silu_f(c[1024 + kb + k]) * w;
    }
    lds[(wave * 2 + 0) * 64 + lane] = a0; lds[(wave * 2 + 1) * 64 + lane] = a1;
    __syncthreads();
    if (tid < 128) { const int b = tid >> 6; float s = 0.f;
#pragma unroll
        for (int w = 0; w < 8; ++w) s += lds[(w * 2 + b) * 64 + lane];
        mod[(size_t)(l * 2 + b) * 6144 + cg * 64 + lane] = s + ada_b[l * 6144 + cg * 64 + lane]; }
    __syncthreads();
}
__device__ __forceinline__ void conv_item(const float* src, int K, int N, bf16_t* dst, int map, int item, int lane) {
    const int nblk = N >> 6, kb = item / nblk, nb = item % nblk, k0 = kb * 32, n = nb * 64 + lane;
    const float* s = src + (size_t)k0 * N + n;
    float v[32];
#pragma unroll
    for (int t = 0; t < 32; ++t) v[t] = s[(size_t)t * N];
    const int slot = map == 1 ? slot_qkv(n) : (map == 2 ? slot_gu(n) : n);
    u32x4* d = (u32x4*)(dst + (size_t)slot * K + k0);
#pragma unroll
    for (int j = 0; j < 4; ++j) { u32x4 o; o.x = pk2(v[8 * j], v[8 * j + 1]); o.y = pk2(v[8 * j + 2], v[8 * j + 3]); o.z = pk2(v[8 * j + 4], v[8 * j + 5]); o.w = pk2(v[8 * j + 6], v[8 * j + 7]); d[j] = o; }
}
constexpr int CI_QKV = 32 * 24, CI_WO = 32 * 16, CI_WIN = 32 * 64, CI_WOUT = 64 * 16, CI_GU1 = 32 * 8, CI_GU = 64 * CI_GU1, CI_DN1 = 8 * 16, CI_DN = 64 * CI_DN1;
constexpr int CI_TOTAL = CI_QKV + CI_WO + CI_WIN + CI_WOUT + CI_GU + CI_DN;

__device__ __forceinline__ void p0_prologue(const Params& p, int wg, int nwg, float* lds) {
    const int tid = fresh_tid(), wave = tid >> 6, lane = tid & 63;
    unsigned char* ws = p.ws;
    if (wg == 0 && tid < 128) ((int*)(ws + WS_CTL))[tid] = 0;
    for (int it = wg; it < 192; it += nwg) mods_item(tid, it, p.in[1], p.in[3], p.in[4], (float*)(ws + WS_MOD), lds);
    const int gw = wg * 8 + wave, ngw = nwg * 8;
    for (int it = gw; it < CI_TOTAL; it += ngw) {
        int r = it;
        if (r < CI_QKV) { conv_item(p.in[7], 1024, 1536, (bf16_t*)(ws + WS_WQKV), 1, r, lane); continue; } r -= CI_QKV;
        if (r < CI_WO) { conv_item(p.in[10], 1024, 1024, (bf16_t*)(ws + WS_WO), 0, r, lane); continue; } r -= CI_WO;
        if (r < CI_WIN) { conv_item(p.in[12], 1024, 4096, (bf16_t*)(ws + WS_WIN), 0, r, lane); continue; } r -= CI_WIN;
        if (r < CI_WOUT) { conv_item(p.in[18], 2048, 1024, (bf16_t*)(ws + WS_WOUT), 0, r, lane); continue; } r -= CI_WOUT;
        if (r < CI_GU) { const int mtx = r / CI_GU1; conv_item(p.in[24] + (size_t)mtx * 1024 * 512, 1024, 512, (bf16_t*)(ws + WS_WGU) + (size_t)mtx * 512 * 1024, 2, r % CI_GU1, lane); continue; } r -= CI_GU;
        { const int mtx = r / CI_DN1; conv_item(p.in[25] + (size_t)mtx * 256 * 1024, 256, 1024, (bf16_t*)(ws + WS_WD) + (size_t)mtx * 1024 * 256, 0, r % CI_DN1, lane); }
    }
    const int gt = wg * 512 + tid, ngt = nwg * 512;
    for (int i = gt; i < 8 * 128 * 128; i += ngt) { const int t = (i >> 7) & 127, s = i & 127; ((bf16_t*)(ws + WS_WS))[i] = (bf16_t)f2bf(s <= t ? p.in[16][i] : 0.f); }
    const int* pos = (const int*)p.in[2];
    for (int i = gt; i < T * 32; i += ngt) {
        const int row = i >> 5, j = i & 31;
        double f = 1.0;
        for (int q = 0; q < j; ++q) f *= 0.7498942093324558;
        const double rev = (double)pos[row] * f * 0.15915494309189535;
        const float fr = (float)(rev - floor(rev));
        ((float*)(ws + WS_ROPE_C))[i] = __builtin_amdgcn_cosf(fr);
        ((float*)(ws + WS_ROPE_S))[i] = __builtin_amdgcn_sinf(fr);
    }
}

__device__ __forceinline__ void phase_h0(const Params& p, int wg, int nwg) {
    const int tid = fresh_tid(), lane = tid & 63, gw = wg * 8 + (tid >> 6), ngw = nwg * 8;
    const float* x = p.in[0]; const float* mod = (const float*)(p.ws + WS_MOD); bf16_t* H = (bf16_t*)(p.ws + WS_H);
    for (int row = gw; row < T; row += ngw) {
        const int b = row >> 13; const float* sh = mod + (size_t)(0 * 2 + b) * 6144; const float* sc = sh + 1024;
#pragma unroll
        for (int j = 0; j < 4; ++j) { const int col = 4 * lane + 256 * j;
            const f32x4 xv = *(const f32x4*)(x + (size_t)row * D + col), s = *(const f32x4*)(sc + col), h = *(const f32x4*)(sh + col);
            const f32x4 o = xv * (s + 1.0f) + h; u32x2 w; w.x = pk2(o.x, o.y); w.y = pk2(o.z, o.w); *(u32x2*)(H + (size_t)row * D + col) = w; }
    }
}
__device__ __forceinline__ void phase_ln_router(const Params& p, int l, const float* z, float* xo, int wg, int nwg, float* lds) {
    const int tid = fresh_tid(), wave = tid >> 6, lane = tid & 63;
    const float* wgr = p.in[20] + (size_t)l * 1024 * 4; const float* bgr = p.in[21] + l * 4;
    const float* wer = p.in[22] + (size_t)l * 1024 * 32; const float* ber = p.in[23] + l * 32;
#pragma unroll 1
    for (int o = 0; o < 36; ++o)
        for (int k = tid; k < 1024; k += 512) lds[o * 1024 + k] = o < 4 ? wgr[k * 4 + o] : wer[k * 32 + (o - 4)];
    __syncthreads();
    const float* lg = p.in[5] + (size_t)(l * 2 + 0) * D; const float* lb = p.in[6] + (size_t)(l * 2 + 0) * D;
    const float* mod = (const float*)(p.ws + WS_MOD); bf16_t* H = (bf16_t*)(p.ws + WS_H);
    int* cnt = (int*)(p.ws + WS_CTL) + l * 32; int* list = (int*)(p.ws + WS_LIST) + (size_t)l * 32 * T; float* wl = (float*)(p.ws + WS_WL) + (size_t)l * 32 * T;
    const int gw = wg * 8 + wave, ngw = nwg * 8;
#pragma unroll 1
    for (int row = gw; row < T; row += ngw) {
        const int b = row >> 13; const float* sh = mod + (size_t)(l * 2 + b) * 6144 + 3 * 1024; const float* sc = sh + 1024;
        f32x4 v[4]; float s = 0.f;
#pragma unroll
        for (int j = 0; j < 4; ++j) { v[j] = *(const f32x4*)(z + (size_t)row * D + 4 * lane + 256 * j); s += (v[j].x + v[j].y) + (v[j].z + v[j].w); }
        const float mean = wave_sum(s) * (1.f / D); float s2 = 0.f;
#pragma unroll
        for (int j = 0; j < 4; ++j) { v[j] = v[j] - mean; s2 += (v[j].x * v[j].x + v[j].y * v[j].y) + (v[j].z * v[j].z + v[j].w * v[j].w); }
        const float rstd = 1.f / sqrtf(wave_sum(s2) * (1.f / D) + LN_EPS);
        f32x4 h[4];
#pragma unroll
        for (int j = 0; j < 4; ++j) { const int col = 4 * lane + 256 * j;
            const f32x4 x1 = v[j] * rstd * *(const f32x4*)(lg + col) + *(const f32x4*)(lb + col);
            *(f32x4*)(xo + (size_t)row * D + col) = x1;
            h[j] = x1 * (*(const f32x4*)(sc + col) + 1.0f) + *(const f32x4*)(sh + col);
            u32x2 w; w.x = pk2(h[j].x, h[j].y); w.y = pk2(h[j].z, h[j].w); *(u32x2*)(H + (size_t)row * D + col) = w; }
        float gl[4];
#pragma unroll
        for (int o = 0; o < 4; ++o) { float a = 0.f;
#pragma unroll
            for (int j = 0; j < 4; ++j) { const f32x4 w = *(const f32x4*)(lds + o * 1024 + 4 * lane + 256 * j); a += (h[j].x * w.x + h[j].y * w.y) + (h[j].z * w.z + h[j].w * w.w); }
            gl[o] = wave_sum(a) + bgr[o]; }
        int g = 0; float gm = gl[0];
#pragma unroll
        for (int o = 1; o < 4; ++o) if (gl[o] > gm) { gm = gl[o]; g = o; }
        float gs = 0.f;
#pragma unroll
        for (int o = 0; o < 4; ++o) gs += expf(gl[o] - gm);
        const float gp = 1.f / gs;
        g = __builtin_amdgcn_readfirstlane(g);
        float v0 = -INFINITY, v1 = -INFINITY; int e0 = 0, e1 = 0;
#pragma unroll 2
        for (int e = 0; e < 8; ++e) { float a = 0.f; const float* wrow = lds + (4 + g * 8 + e) * 1024;
#pragma unroll
            for (int j = 0; j < 4; ++j) { const f32x4 w = *(const f32x4*)(wrow + 4 * lane + 256 * j); a += (h[j].x * w.x + h[j].y * w.y) + (h[j].z * w.z + h[j].w * w.w); }
            const float val = wave_sum(a) + ber[g * 8 + e];
            if (val > v0) { v1 = v0; e1 = e0; v0 = val; e0 = e; } else if (val > v1) { v1 = val; e1 = e; } }
        const float w0 = 1.f / (1.f + expf(v1 - v0)), w1 = 1.f - w0;
        if (lane == 0) {
            const int ea = g * 8 + e0, eb = g * 8 + e1;
            const int pa = atomicAdd(cnt + ea, 1); list[(size_t)ea * T + pa] = row * 2 + 0; wl[(size_t)ea * T + pa] = w0 * gp;
            const int pb = atomicAdd(cnt + eb, 1); list[(size_t)eb * T + pb] = row * 2 + 1; wl[(size_t)eb * T + pb] = w1 * gp;
        }
    }
}
__device__ __forceinline__ void phase_ln2(const Params& p, int l, const float* x1, float* xo, int nextl, int wg, int nwg) {
    const int tid = fresh_tid(), lane = tid & 63, gw = wg * 8 + (tid >> 6), ngw = nwg * 8;
    const float* lg = p.in[5] + (size_t)(l * 2 + 1) * D; const float* lb = p.in[6] + (size_t)(l * 2 + 1) * D;
    const float* mod = (const float*)(p.ws + WS_MOD); bf16_t* H = (bf16_t*)(p.ws + WS_H); const bf16_t* y2 = (const bf16_t*)(p.ws + WS_RA + RA_Y2);
    for (int row = gw; row < T; row += ngw) {
        const int b = row >> 13; const float* gt = mod + (size_t)(l * 2 + b) * 6144 + 5 * 1024;
        f32x4 v[4]; float s = 0.f;
#pragma unroll
        for (int j = 0; j < 4; ++j) { const int col = 4 * lane + 256 * j;
            const f32x4 xv = *(const f32x4*)(x1 + (size_t)row * D + col), g = *(const f32x4*)(gt + col);
            const u32x2 ya = *(const u32x2*)(y2 + ((size_t)row * 2 + 0) * D + col), yb = *(const u32x2*)(y2 + ((size_t)row * 2 + 1) * D + col);
            f32x4 y; y.x = __builtin_bit_cast(float, ya.x << 16) + __builtin_bit_cast(float, yb.x << 16); y.y = __builtin_bit_cast(float, ya.x & 0xffff0000u) + __builtin_bit_cast(float, yb.x & 0xffff0000u);
            y.z = __builtin_bit_cast(float, ya.y << 16) + __builtin_bit_cast(float, yb.y << 16); y.w = __builtin_bit_cast(float, ya.y & 0xffff0000u) + __builtin_bit_cast(float, yb.y & 0xffff0000u);
            v[j] = xv * ALPHA + (g + 1.0f) * y; s += (v[j].x + v[j].y) + (v[j].z + v[j].w); }
        const float mean = wave_sum(s) * (1.f / D); float s2 = 0.f;
#pragma unroll
        for (int j = 0; j < 4; ++j) { v[j] = v[j] - mean; s2 += (v[j].x * v[j].x + v[j].y * v[j].y) + (v[j].z * v[j].z + v[j].w * v[j].w); }
        const float rstd = 1.f / sqrtf(wave_sum(s2) * (1.f / D) + LN_EPS);
        const float* sh = mod + (size_t)((nextl < 0 ? 0 : nextl) * 2 + b) * 6144; const float* sc = sh + 1024;
#pragma unroll
        for (int j = 0; j < 4; ++j) { const int col = 4 * lane + 256 * j;
            const f32x4 x2 = v[j] * rstd * *(const f32x4*)(lg + col) + *(const f32x4*)(lb + col);
            *(f32x4*)(xo + (size_t)row * D + col) = x2;
            if (nextl >= 0) { const f32x4 h = x2 * (*(const f32x4*)(sc + col) + 1.0f) + *(const f32x4*)(sh + col);
                u32x2 w; w.x = pk2(h.x, h.y); w.y = pk2(h.z, h.w); *(u32x2*)(H + (size_t)row * D + col) = w; } }
    }
}

__global__ void __launch_bounds__(512) k_prologue(Params p) { __shared__ float lds[1024]; p0_prologue(p, blockIdx.x, gridDim.x, lds); }
__global__ void __launch_bounds__(512) k_h0(Params p) { phase_h0(p, blockIdx.x, gridDim.x); }
__global__ void __launch_bounds__(512) k_ln_router(KA a) { extern __shared__ float dl[]; phase_ln_router(a.p, a.i0, a.a, a.b, blockIdx.x, gridDim.x, dl); }
__global__ void __launch_bounds__(512) k_ln2(KA a) { phase_ln2(a.p, a.i0, a.a, a.b, a.i1, blockIdx.x, gridDim.x); }

struct NG { const bf16_t* A; const int* rowmap; const bf16_t* Bt; const int* tile_expert; const int* ntiles; size_t estride; int lda, ldb, K, pad; };
template <class Epi> __global__ void __launch_bounds__(256) ngemm(NG g, Epi E) {
    __shared__ float As[16][68], Bs[16][68];
    const int tid = threadIdx.x, tx = tid & 15, ty = tid >> 4;
    const int m0 = blockIdx.y * 64, n0 = blockIdx.x * 64;
    const bf16_t* Bt = g.Bt;
    if (g.tile_expert) { if ((m0 >> 8) >= *g.ntiles) return; Bt += (size_t)g.tile_expert[m0 >> 8] * g.estride; }
    const int lr = tid >> 2, kq = tid & 3;
    int arow = m0 + lr; if (g.rowmap) { const int rm = g.rowmap[arow]; arow = rm < 0 ? 0 : (rm >> 1); }
    const bf16_t* ap = g.A + (size_t)arow * g.lda + kq * 4; const bf16_t* bp = Bt + (size_t)(n0 + lr) * g.ldb + kq * 4;
    float acc[4][4];
#pragma unroll
    for (int i = 0; i < 4; ++i)
#pragma unroll
        for (int j = 0; j < 4; ++j) acc[i][j] = 0.f;
    for (int k0 = 0; k0 < g.K; k0 += 16) {
        const u32x2 av = *(const u32x2*)(ap + k0), bv = *(const u32x2*)(bp + k0);
        __syncthreads();
        As[kq * 4 + 0][lr] = __builtin_bit_cast(float, av.x << 16); As[kq * 4 + 1][lr] = __builtin_bit_cast(float, av.x & 0xffff0000u);
        As[kq * 4 + 2][lr] = __builtin_bit_cast(float, av.y << 16); As[kq * 4 + 3][lr] = __builtin_bit_cast(float, av.y & 0xffff0000u);
        Bs[kq * 4 + 0][lr] = __builtin_bit_cast(float, bv.x << 16); Bs[kq * 4 + 1][lr] = __builtin_bit_cast(float, bv.x & 0xffff0000u);
        Bs[kq * 4 + 2][lr] = __builtin_bit_cast(float, bv.y << 16); Bs[kq * 4 + 3][lr] = __builtin_bit_cast(float, bv.y & 0xffff0000u);
        __syncthreads();
#pragma unroll
        for (int k = 0; k < 16; ++k) {
            const f32x4 a = *(const f32x4*)&As[k][ty * 4], b = *(const f32x4*)&Bs[k][tx * 4];
#pragma unroll
            for (int i = 0; i < 4; ++i)
#pragma unroll
                for (int j = 0; j < 4; ++j) acc[i][j] += a[i] * b[j];
        }
    }
#pragma unroll
    for (int i = 0; i < 4; ++i)
#pragma unroll
        for (int j = 0; j < 4; ++j) E(m0 + ty * 4 + i, n0 + tx * 4 + j, acc[i][j]);
}
struct NEpiF32 { float* C; int ldc, pad; __device__ void operator()(int r, int c, float v) const { C[(size_t)r * ldc + c] = v; } };
struct NEpiResid { const float* x; const float* bias; const float* gt  ; float* z;
    __device__ void operator()(int r, int c, float v) const { const int b = r >> 13; z[(size_t)r * D + c] = ALPHA * x[(size_t)r * D + c] + (1.f + gt[b * 6144 + c]) * (v + bias[c]); } };
struct NEpiGelu { const float* bias; bf16_t* U; bf16_t* V;
    __device__ void operator()(int r, int c, float v) const { const float a = v + bias[c]; const float g = 0.5f * a * (1.f + erff(a * 0.70710678118654752f));
        if (c < GW) U[(size_t)r * GW + c] = (bf16_t)f2bf(g); else V[(size_t)r * GW + c - GW] = (bf16_t)f2bf(g); } };
struct NEpiMoe2 { const int* rowmap; bf16_t* y2; __device__ void operator()(int r, int c, float v) const { const int rm = rowmap[r]; if (rm >= 0) y2[(size_t)rm * D + c] = (bf16_t)f2bf(v); } };

__global__ void k_rope_post(Params p) {
    const size_t i = (size_t)blockIdx.x * 256 + threadIdx.x; if (i >= (size_t)T * 768) return;
    const int row = (int)(i / 768), q = (int)(i % 768);
    const int tile = q / 128, hl = (q % 128) / 32, dp = q % 32;
    const float* raw = (const float*)(p.ws + WS_RA + RA_QKVRAW) + (size_t)row * NQKV + tile * 256;
    const float* bq = p.in[8];
    int scol; bf16_t* dst; float sc = 1.f; int ld;
    if (tile < 4) { scol = (tile * 4 + hl) * 64; dst = (bf16_t*)(p.ws + WS_RA + RA_Q) + (size_t)row * 1024 + scol; sc = QSCALE; }
    else if (tile == 4) { scol = 1024 + hl * 64; dst = (bf16_t*)(p.ws + WS_RA + RA_K) + (size_t)row * 256 + hl * 64; }
    else { scol = 1280 + hl * 64; dst = (bf16_t*)(p.ws + WS_RA + RA_V) + (size_t)row * 256 + hl * 64; }
    const float x1 = raw[hl * 32 + dp] + bq[scol + dp], x2 = raw[128 + hl * 32 + dp] + bq[scol + 32 + dp];
    float o1 = x1, o2 = x2;
    if (tile < 5) { const float cs = ((const float*)(p.ws + WS_ROPE_C))[(size_t)row * 32 + dp], sn = ((const float*)(p.ws + WS_ROPE_S))[(size_t)row * 32 + dp];
        o1 = x1 * cs - x2 * sn; o2 = x2 * cs + x1 * sn; }
    dst[dp] = (bf16_t)f2bf(o1 * sc); dst[32 + dp] = (bf16_t)f2bf(o2 * sc);
    (void)ld;
}
__global__ void __launch_bounds__(256) k_attn_naive(Params p) {
    const int w = blockIdx.x * 4 + (threadIdx.x >> 6), lane = threadIdx.x & 63;
    const int row = w >> 4, hq = w & 15, kvh = hq >> 2, s = row & (SEQ - 1);
    const bf16_t* Q = (const bf16_t*)(p.ws + WS_RA + RA_Q) + (size_t)row * 1024 + hq * 64;
    const bf16_t* Kb = (const bf16_t*)(p.ws + WS_RA + RA_K); const bf16_t* Vb = (const bf16_t*)(p.ws + WS_RA + RA_V);
    float q[64];
#pragma unroll
    for (int i = 0; i < 8; ++i) { const u32x4 v = *(const u32x4*)(Q + i * 8);
        q[8 * i] = __builtin_bit_cast(float, v.x << 16); q[8 * i + 1] = __builtin_bit_cast(float, v.x & 0xffff0000u); q[8 * i + 2] = __builtin_bit_cast(float, v.y << 16); q[8 * i + 3] = __builtin_bit_cast(float, v.y & 0xffff0000u);
        q[8 * i + 4] = __builtin_bit_cast(float, v.z << 16); q[8 * i + 5] = __builtin_bit_cast(float, v.z & 0xffff0000u); q[8 * i + 6] = __builtin_bit_cast(float, v.w << 16); q[8 * i + 7] = __builtin_bit_cast(float, v.w & 0xffff0000u); }
    float sc[2];
#pragma unroll
    for (int h = 0; h < 2; ++h) { const int ks = s - 127 + h * 64 + lane; float a = -INFINITY;
        if (ks >= 0) { const bf16_t* kr = Kb + (size_t)(row - s + ks) * 256 + kvh * 64; a = 0.f;
#pragma unroll
            for (int i = 0; i < 8; ++i) { const u32x4 v = *(const u32x4*)(kr + i * 8);
                a += q[8 * i] * __builtin_bit_cast(float, v.x << 16) + q[8 * i + 1] * __builtin_bit_cast(float, v.x & 0xffff0000u) + q[8 * i + 2] * __builtin_bit_cast(float, v.y << 16) + q[8 * i + 3] * __builtin_bit_cast(float, v.y & 0xffff0000u)
                   + q[8 * i + 4] * __builtin_bit_cast(float, v.z << 16) + q[8 * i + 5] * __builtin_bit_cast(float, v.z & 0xffff0000u) + q[8 * i + 6] * __builtin_bit_cast(float, v.w << 16) + q[8 * i + 7] * __builtin_bit_cast(float, v.w & 0xffff0000u); } }
        sc[h] = a; }
    const float sink = p.in[9][hq] * LOG2E;
    const float m = fmaxf(wave_max(fmaxf(sc[0], sc[1])), sink);
    const float p0 = exp2f(sc[0] - m), p1 = exp2f(sc[1] - m);
    const float den = wave_sum(p0 + p1) + exp2f(sink - m);
    float o = 0.f;
    for (int j = 0; j < 64; ++j) {
        const float a0 = __shfl(p0, j), a1 = __shfl(p1, j);
        const int k0 = s - 127 + j, k1 = s - 63 + j;
        if (k0 >= 0) o += a0 * bf2f(Vb[(size_t)(row - s + k0) * 256 + kvh * 64 + lane]);
        if (k1 >= 0) o += a1 * bf2f(Vb[(size_t)(row - s + k1) * 256 + kvh * 64 + lane]);
    }
    ((bf16_t*)(p.ws + WS_RA + RA_O))[(size_t)row * 1024 + hq * 64 + lane] = (bf16_t)f2bf(o / den);
}
__global__ void __launch_bounds__(256) k_vstat_naive(Params p) {
    const int row = blockIdx.x * 4 + (threadIdx.x >> 6), lane = threadIdx.x & 63;
    const bf16_t* v = (const bf16_t*)(p.ws + WS_RA + RA_V2) + (size_t)row * GW;
    float s = 0.f, s2 = 0.f;
    for (int i = lane; i < GW; i += 64) { const float a = bf2f(v[i]); s += a; s2 += a * a; }
    s = wave_sum(s); s2 = wave_sum(s2);
    const float mean = s * (1.f / GW), var = fmaxf(s2 * (1.f / GW) - mean * mean, 0.f);
    if (lane == 0) { float* rs = (float*)(p.ws + WS_ROWSTAT) + (size_t)row * 2; rs[0] = mean; rs[1] = 1.f / sqrtf(var + LN_EPS); }
    if (lane < 32) { f32x2v o; o.x = lane == 0 ? s : 0.f; o.y = lane == 0 ? s2 : 0.f; *(f32x2v*)((float*)(p.ws + WS_VSTAT) + ((size_t)row * 32 + lane) * 2) = o; }
}
__global__ void __launch_bounds__(256) k_vstat_bridge(Params p) {
    const int row = blockIdx.x * 256 + threadIdx.x; const float* ps = (const float*)(p.ws + WS_VSTAT) + (size_t)row * 64;
    float s = 0.f, s2 = 0.f;
    for (int i = 0; i < 32; ++i) { s += ps[2 * i]; s2 += ps[2 * i + 1]; }
    const float mean = s * (1.f / GW), var = fmaxf(s2 * (1.f / GW) - mean * mean, 0.f);
    float* rs = (float*)(p.ws + WS_ROWSTAT) + (size_t)row * 2; rs[0] = mean; rs[1] = 1.f / sqrtf(var + LN_EPS);
}
__global__ void __launch_bounds__(256) k_gate_naive(Params p) {
    const size_t i = (size_t)blockIdx.x * 256 + threadIdx.x;
    const int t = (int)(i >> 11), c = (int)(i & 2047), tt = t & 127, t0 = t - tt, g = c >> 8;
    const bf16_t* v = (const bf16_t*)(p.ws + WS_RA + RA_V2); const bf16_t* u = (const bf16_t*)(p.ws + WS_RA + RA_U);
    const bf16_t* w = (const bf16_t*)(p.ws + WS_WS) + (size_t)(g * 128 + tt) * 128; const float* rs = (const float*)(p.ws + WS_ROWSTAT);
    const float lg = p.in[14][c], lb = p.in[15][c];
    float a = 0.f;
    for (int s = 0; s <= tt; ++s) { const float vn = (bf2f(v[(size_t)(t0 + s) * GW + c]) - rs[(size_t)(t0 + s) * 2]) * rs[(size_t)(t0 + s) * 2 + 1] * lg + lb; a += bf2f(w[s]) * vn; }
    a += p.in[17][g * 128 + tt];
    ((bf16_t*)(p.ws + WS_RA + RA_GATED))[i] = (bf16_t)f2bf(bf2f(u[i]) * a);
}
__global__ void __launch_bounds__(256) k_moe_prep(KA ka) {
    const Params& p = ka.p; const int l = ka.i0;
    __shared__ int tb[33];
    const int* cnt = (const int*)(p.ws + WS_CTL) + l * 32; const int* list = (const int*)(p.ws + WS_LIST) + (size_t)l * 32 * T; const float* wl = (const float*)(p.ws + WS_WL) + (size_t)l * 32 * T;
    int* rowmap = (int*)(p.ws + WS_TAB); float* wrow = (float*)(p.ws + WS_TAB) + MPAD; int* te = (int*)(p.ws + WS_TAB) + 2 * MPAD; int* nt = (int*)(p.ws + WS_CTL) + 64 + l;
    if (threadIdx.x == 0) { int a = 0; for (int e = 0; e < 32; ++e) { tb[e] = a; a += (cnt[e] + 255) >> 8; } tb[32] = a; *nt = a; }
    __syncthreads();
    for (int e = 0; e < 32; ++e) {
        const int n = cnt[e];
        for (int tl = tb[e]; tl < tb[e + 1]; ++tl) { if (threadIdx.x == 0) te[tl] = e;
            const int idx = (tl - tb[e]) * 256 + threadIdx.x; rowmap[tl * 256 + threadIdx.x] = idx < n ? list[(size_t)e * T + idx] : -1; wrow[tl * 256 + threadIdx.x] = idx < n ? wl[(size_t)e * T + idx] : 0.f; }
    }
}
__global__ void __launch_bounds__(256) k_moe1_post(KA ka) {
    const Params& p = ka.p; const int l = ka.i0;
    const size_t i = (size_t)blockIdx.x * 256 + threadIdx.x; const int m = (int)(i >> 8), c = (int)(i & 255);
    const int nt = ((const int*)(p.ws + WS_CTL))[64 + l]; if (m >= nt * 256) return;
    const float* gu = (const float*)(p.ws + WS_RA + RA_GURAW) + (size_t)m * 512; const float w = ((const float*)(p.ws + WS_TAB))[MPAD + m];
    const int pn = c >> 7, j = c & 127; const float g = gu[pn * 256 + j], u = gu[pn * 256 + 128 + j];
    ((bf16_t*)(p.ws + WS_RA + RA_ACT))[i] = (bf16_t)f2bf(silu_f(g) * u * w);
}


namespace pg8 {
#define PG8_LAS __attribute__((address_space(3)))
typedef short bf16x8 __attribute__((ext_vector_type(8)));
typedef float f32x2 __attribute__((ext_vector_type(2)));
constexpr int BM = 256, BK = 64, HALF = 128, HTB = HALF * BK * 2  , STAGE_BYTES = 8 * HTB, NXCD = 8, WGM = 8;

__host__ __device__ __forceinline__ int lds_byte(int r, int c) { const int st = (r >> 4) * 2 + (c >> 5), rr = r & 15, cc = c & 31, ob = rr * 64 + cc * 2; return st * 1024 + (ob ^ (((ob >> 9) & 1) << 5)); }
__host__ __device__ __forceinline__ void stage_rc(int b, int& R, int& C) { const int st = b / 1024, sb = b % 1024, swz = sb ^ (((sb >> 9) & 1) << 5); R = (st >> 1) * 16 + swz / 64; C = (st & 1) * 32 + (swz % 64) / 2; }
__host__ __device__ __forceinline__ int perm32(int rho) { const int n = rho >> 4, i = rho & 15; return 8 * (i >> 2) + 4 * n + (i & 3); }

struct Unit { int pm, pn; };
struct Gemm { const bf16_t* A; const bf16_t* Bt; int lda, ldb, K; };

struct StaticOrder {
    static constexpr bool GATHER = false;
    int nM, nN, nwg, G, c;
    __device__ void init(int M, int N, int G_, int c_) { nM = M / BM; nN = N / BM; nwg = nM * nN; G = G_; c = c_; }
    __device__ bool next(int i, Unit& u) const {
        const long L = (long)i * G + c; if (L >= nwg) return false;
        int wgid = (int)L; { const int q = nwg / NXCD, r = nwg % NXCD, xcd = wgid % NXCD, off = wgid / NXCD; wgid = (xcd < r ? xcd * (q + 1) : r * (q + 1) + (xcd - r) * q) + off; }
        const int nig = WGM * nN, gid = wgid / nig, fm = gid * WGM, gsz = (nM - fm) < WGM ? (nM - fm) : WGM;
        u.pm = fm + ((wgid % nig) % gsz); u.pn = (wgid % nig) / gsz; return true;
    }
    __device__ __forceinline__ const char* abase(const Gemm& g, const Unit& u) const { return (const char*)g.A + (size_t)u.pm * BM * g.lda * 2; }
    __device__ __forceinline__ const char* bbase(const Gemm& g, const Unit& u) const { return (const char*)g.Bt + (size_t)u.pn * BM * g.ldb * 2; }
    __device__ __forceinline__ unsigned arow(const Unit&, int) const { return 0u; }
};
template <bool GATHER_, int NPN_LOG2> struct MoeOrder {
    static constexpr bool GATHER = GATHER_;
    const PG8_LAS int* tab; const int* list; size_t bstride; int G, c;
    __device__ bool next(int i, Unit& u) const { const int L = i * G + c; if (L >= (tab[0] << NPN_LOG2)) return false; u.pm = L >> NPN_LOG2; u.pn = L & ((1 << NPN_LOG2) - 1); return true; }
    __device__ __forceinline__ const char* abase(const Gemm& g, const Unit& u) const { return GATHER_ ? (const char*)g.A : (const char*)g.A + (size_t)u.pm * BM * g.lda * 2; }
    __device__ __forceinline__ const char* bbase(const Gemm& g, const Unit& u) const { return (const char*)g.Bt + (size_t)tab[64 + u.pm] * bstride + (size_t)u.pn * BM * g.ldb * 2; }
    __device__ __forceinline__ unsigned arow(const Unit& u, int r) const { const int e = tab[64 + u.pm], idx = tab[224 + u.pm] + r; return idx < tab[1 + e] ? (unsigned)(list[(size_t)e * T + idx] >> 1) : 0u; }
};

__device__ __forceinline__ unsigned cvt_pk_bf16(float lo, float hi) { unsigned r; asm volatile("v_cvt_pk_bf16_f32 %0, %1, %2" : "=v"(r) : "v"(lo), "v"(hi)); return r; }
__device__ __forceinline__ f32x2 gelu_pk(f32x2 v) {
    const f32x2 av = __builtin_elementwise_abs(v), d = av * 0.2316418882f + 1.0f;
    f32x2 t; t.x = __builtin_amdgcn_rcpf(d.x); t.y = __builtin_amdgcn_rcpf(d.y);
    f32x2 q = t * 0.5307027145f + (-0.7265760135f); q = q * t + 0.7107068705f; q = q * t + (-0.142248368f); q = q * t + 0.127414796f; q = q * t;
    const f32x2 s = (v * v) * (-0.72134752044f);
    f32x2 e; e.x = __builtin_amdgcn_exp2f(s.x); e.y = __builtin_amdgcn_exp2f(s.y);
    const f32x2 m = v * (q * e), r = v - m;
    f32x2 o; o.x = v.x < 0.f ? m.x : r.x; o.y = v.y < 0.f ? m.y : r.y; return o;
}

typedef f32x4 Acc[2][2][4][2];

struct EpiQKV {
    static constexpr bool PERM = true;
    const float* bias; const float* rc; const float* rs; bf16_t* Q; bf16_t* Kb; bf16_t* Vb;
    __device__ __forceinline__ void operator()(const Acc& acc, const Unit& u, int wr, int wc, int fr, int fq) const {
        const int tile = u.pn; int scol; bf16_t* dst; int ld; float sc = 1.f;
        if (tile < 4) { scol = (tile * 4 + wc) * 64; dst = Q + scol; ld = 1024; sc = QSCALE; }
        else if (tile == 4) { scol = 1024 + wc * 64; dst = Kb + wc * 64; ld = 256; }
        else { scol = 1280 + wc * 64; dst = Vb + wc * 64; ld = 256; }
        f32x4 b1[2], b2[2];
#pragma unroll
        for (int n = 0; n < 2; ++n) { b1[n] = *(const f32x4*)(bias + scol + 8 * fq + 4 * n); b2[n] = *(const f32x4*)(bias + scol + 32 + 8 * fq + 4 * n); }
#pragma unroll
        for (int ai = 0; ai < 2; ++ai)
#pragma unroll
            for (int m = 0; m < 4; ++m) {
                const int row = u.pm * BM + ai * HALF + wr * 64 + m * 16 + fr;
                f32x4 o1[2], o2[2];
#pragma unroll
                for (int n = 0; n < 2; ++n) {
                    const f32x4 x1 = acc[ai][0][m][n] + b1[n], x2 = acc[ai][1][m][n] + b2[n];
                    if (tile < 5) { const f32x4 cs = *(const f32x4*)(rc + (size_t)row * 32 + 8 * fq + 4 * n), sn = *(const f32x4*)(rs + (size_t)row * 32 + 8 * fq + 4 * n);
                        o1[n] = (x1 * cs - x2 * sn) * sc; o2[n] = (x2 * cs + x1 * sn) * sc; }
                    else { o1[n] = x1; o2[n] = x2; }
                }
                u32x4 w1, w2;
                w1.x = cvt_pk_bf16(o1[0][0], o1[0][1]); w1.y = cvt_pk_bf16(o1[0][2], o1[0][3]); w1.z = cvt_pk_bf16(o1[1][0], o1[1][1]); w1.w = cvt_pk_bf16(o1[1][2], o1[1][3]);
                w2.x = cvt_pk_bf16(o2[0][0], o2[0][1]); w2.y = cvt_pk_bf16(o2[0][2], o2[0][3]); w2.z = cvt_pk_bf16(o2[1][0], o2[1][1]); w2.w = cvt_pk_bf16(o2[1][2], o2[1][3]);
                bf16_t* rp = dst + (size_t)row * ld + 8 * fq;
                *(u32x4*)rp = w1; *(u32x4*)(rp + 32) = w2;
            }
    }
};
struct EpiResid {
    static constexpr bool PERM = false;
    const float* x; const float* bias; const float* gt; float* z;
    __device__ __forceinline__ void operator()(const Acc& acc, const Unit& u, int wr, int wc, int fr, int fq) const {
        const int col0 = u.pn * BM + wc * 32 + 4 * fq; const int b = (u.pm * BM) >> 13;
        f32x4 bv[2][2], gv[2][2];
#pragma unroll
        for (int bj = 0; bj < 2; ++bj)
#pragma unroll
            for (int n = 0; n < 2; ++n) { bv[bj][n] = *(const f32x4*)(bias + col0 + bj * HALF + n * 16); gv[bj][n] = *(const f32x4*)(gt + b * 6144 + col0 + bj * HALF + n * 16) + 1.0f; }
#pragma unroll
        for (int ai = 0; ai < 2; ++ai)
#pragma unroll
            for (int m = 0; m < 4; ++m) { const size_t off = (size_t)(u.pm * BM + ai * HALF + wr * 64 + m * 16 + fr) * D + col0;
#pragma unroll
                for (int bj = 0; bj < 2; ++bj)
#pragma unroll
                    for (int n = 0; n < 2; ++n) { const f32x4 xv = *(const f32x4*)(x + off + bj * HALF + n * 16);
                        *(f32x4*)(z + off + bj * HALF + n * 16) = xv * ALPHA + gv[bj][n] * (acc[ai][bj][m][n] + bv[bj][n]); }
                if (m & 1) asm volatile("" ::: "memory"); }
    }
};
struct EpiGeluUV {
    static constexpr bool PERM = true;
    const float* bias; bf16_t* U; bf16_t* V2; float* vstat;
    __device__ __forceinline__ void operator()(const Acc& acc, const Unit& u, int wr, int wc, int fr, int fq) const {
        const bool isv = u.pn >= 8; bf16_t* base = isv ? V2 : U; const int colt = (isv ? u.pn - 8 : u.pn) * BM;
        const int col0 = colt + wc * 32 + 8 * fq, bcol0 = u.pn * BM + wc * 32 + 8 * fq;
        f32x4 bv[2][2];
#pragma unroll
        for (int bj = 0; bj < 2; ++bj)
#pragma unroll
            for (int n = 0; n < 2; ++n) bv[bj][n] = *(const f32x4*)(bias + bcol0 + bj * HALF + 4 * n);
#pragma unroll
        for (int ai = 0; ai < 2; ++ai)
#pragma unroll
            for (int m = 0; m < 4; ++m) { const int row = u.pm * BM + ai * HALF + wr * 64 + m * 16 + fr; bf16_t* rowp = base + (size_t)row * GW + col0; float s = 0.f, s2 = 0.f;
#pragma unroll
                for (int bj = 0; bj < 2; ++bj) { f32x4 v0 = acc[ai][bj][m][0] + bv[bj][0], v1 = acc[ai][bj][m][1] + bv[bj][1];
                    const f32x2 a = gelu_pk((f32x2){v0[0], v0[1]}), bb = gelu_pk((f32x2){v0[2], v0[3]}), c = gelu_pk((f32x2){v1[0], v1[1]}), d = gelu_pk((f32x2){v1[2], v1[3]});
                    s += (a.x + a.y) + (bb.x + bb.y) + (c.x + c.y) + (d.x + d.y);
                    s2 += (a.x * a.x + a.y * a.y) + (bb.x * bb.x + bb.y * bb.y) + (c.x * c.x + c.y * c.y) + (d.x * d.x + d.y * d.y);
                    u32x4 w; w.x = cvt_pk_bf16(a.x, a.y); w.y = cvt_pk_bf16(bb.x, bb.y); w.z = cvt_pk_bf16(c.x, c.y); w.w = cvt_pk_bf16(d.x, d.y);
                    *(u32x4*)(rowp + bj * HALF) = w; }
                if (isv) { s += __shfl_xor(s, 16); s += __shfl_xor(s, 32); s2 += __shfl_xor(s2, 16); s2 += __shfl_xor(s2, 32);
                    if (fq == 0) *(f32x2*)(vstat + ((size_t)row * 32 + (u.pn - 8) * 4 + wc) * 2) = (f32x2){s, s2}; } }
    }
};
struct EpiMoe1 {
    static constexpr bool PERM = true;
    const PG8_LAS int* tab; const float* wl; bf16_t* act;
    __device__ __forceinline__ void operator()(const Acc& acc, const Unit& u, int wr, int wc, int fr, int fq) const {
        const int e = tab[64 + u.pm], r0 = tab[224 + u.pm], n_e = tab[1 + e];
        const int col0 = u.pn * HALF + wc * 32 + 8 * fq;
#pragma unroll
        for (int ai = 0; ai < 2; ++ai)
#pragma unroll
            for (int m = 0; m < 4; ++m) { const int rl = ai * HALF + wr * 64 + m * 16 + fr; const int idx = r0 + rl;
                const float w = idx < n_e ? wl[(size_t)e * T + idx] : 0.f;
                f32x4 o[2];
#pragma unroll
                for (int n = 0; n < 2; ++n) { const f32x4 g = acc[ai][0][m][n], up = acc[ai][1][m][n];
#pragma unroll
                    for (int i = 0; i < 4; ++i) { const float sg = g[i] * __builtin_amdgcn_rcpf(1.f + __builtin_amdgcn_exp2f(-g[i] * LOG2E)); o[n][i] = idx < n_e ? sg * up[i] * w : 0.f; } }
                u32x4 wv; wv.x = cvt_pk_bf16(o[0][0], o[0][1]); wv.y = cvt_pk_bf16(o[0][2], o[0][3]); wv.z = cvt_pk_bf16(o[1][0], o[1][1]); wv.w = cvt_pk_bf16(o[1][2], o[1][3]);
                *(u32x4*)(act + (size_t)(u.pm * BM + rl) * EFF + col0) = wv; }
    }
};
struct EpiMoe2 {
    static constexpr bool PERM = true;
    const PG8_LAS int* tab; const int* list; bf16_t* y2;
    __device__ __forceinline__ void operator()(const Acc& acc, const Unit& u, int wr, int wc, int fr, int fq) const {
        const int e = tab[64 + u.pm], r0 = tab[224 + u.pm], n_e = tab[1 + e];
        const int col0 = u.pn * BM + wc * 32 + 8 * fq; const int* lp = list + (size_t)e * T + r0 + wr * 64 + fr;
#pragma unroll
        for (int ai = 0; ai < 2; ++ai) {
            int ts[4];
#pragma unroll
            for (int m = 0; m < 4; ++m) { const int idx = r0 + ai * HALF + wr * 64 + m * 16 + fr; ts[m] = idx < n_e ? lp[ai * HALF + m * 16] : -1; }
#pragma unroll
            for (int m = 0; m < 4; ++m) {
                if (ts[m] >= 0) { bf16_t* rowp = y2 + (size_t)ts[m] * D + col0;
#pragma unroll
                    for (int bj = 0; bj < 2; ++bj) { const f32x4 v0 = acc[ai][bj][m][0], v1 = acc[ai][bj][m][1];
                        u32x4 w; w.x = cvt_pk_bf16(v0[0], v0[1]); w.y = cvt_pk_bf16(v0[2], v0[3]); w.z = cvt_pk_bf16(v1[0], v1[1]); w.w = cvt_pk_bf16(v1[2], v1[3]);
                        *(u32x4*)(rowp + bj * HALF) = w; } }
                asm volatile("" ::: "memory"); }
        }
    }
};

template <class Epi, class Sched, bool ALIGN_EPI>
__device__ __forceinline__ void gemm_phase(PG8_LAS unsigned char* lds, const Gemm g, const Sched& S, const Epi& E) {
    const int tid = fresh_tid();
    const int wid = __builtin_amdgcn_readfirstlane(tid >> 6), lane = tid & 63, wr = wid >> 2, wc = wid & 3, fr = lane & 15, fq = lane >> 4;
    const int K = g.K, nt = K / BK;
    int RA[2], CA[2]; unsigned voffB[2][2], cvA[2][2], nvA[2][2];
#pragma unroll
    for (int i = 0; i < 2; ++i) { int R, C; stage_rc(tid * 16 + i * 8192, R, C); const int Rb = Epi::PERM ? ((R & ~31) + perm32(R & 31)) : R; RA[i] = R; CA[i] = C;
#pragma unroll
        for (int h = 0; h < 2; ++h) { voffB[h][i] = (unsigned)((Rb + h * HALF) * g.ldb + C) * 2u; cvA[h][i] = (unsigned)((R + h * HALF) * g.lda + C) * 2u; nvA[h][i] = cvA[h][i]; } }
    const size_t kstep = (size_t)(BK * 2);
    const unsigned ldsw = (unsigned)wid * 1024u;
    const int aoff = lds_byte(wr * 64 + fr, fq * 8), boff = lds_byte(wc * 32 + fr, fq * 8);
#define PG8_SA(b, h) (((b) * 2 + (h)) * HTB)
#define PG8_SB(b, h) ((4 + (b) * 2 + (h)) * HTB)
#define PG8_STAGE(bufoff, gbase, voff) do { _Pragma("unroll") for (int _i = 0; _i < 2; ++_i) \
        __builtin_amdgcn_global_load_lds((const unsigned*)((const char*)(gbase) + (voff)[_i]), (PG8_LAS unsigned*)(lds + (bufoff) + ldsw + _i * 8192), 16, 0, 0); } while (0)
#define PG8_LDA(dst, b, h) do { _Pragma("unroll") for (int m = 0; m < 4; ++m) _Pragma("unroll") for (int k = 0; k < 2; ++k) dst[m][k] = *(const PG8_LAS bf16x8*)(lds + PG8_SA(b, h) + aoff + m * 2048 + k * 1024); } while (0)
#define PG8_LDB(dst, b, h) do { _Pragma("unroll") for (int n = 0; n < 2; ++n) _Pragma("unroll") for (int k = 0; k < 2; ++k) dst[n][k] = *(const PG8_LAS bf16x8*)(lds + PG8_SB(b, h) + boff + n * 2048 + k * 1024); } while (0)
#define PG8_MMA(ai, bj, At, Bt) do { __builtin_amdgcn_s_setprio(1); _Pragma("unroll") for (int m = 0; m < 4; ++m) _Pragma("unroll") for (int n = 0; n < 2; ++n) _Pragma("unroll") for (int k = 0; k < 2; ++k) \
        acc[ai][bj][m][n] = __builtin_amdgcn_mfma_f32_16x16x32_bf16(Bt[n][k], At[m][k], acc[ai][bj][m][n], 0, 0, 0); __builtin_amdgcn_s_setprio(0); } while (0)
#define PG8_WAIT_V(n) asm volatile("s_waitcnt vmcnt(" #n ")" ::: "memory")
#define PG8_WAIT_L(n) asm volatile("s_waitcnt lgkmcnt(" #n ")" ::: "memory")
#define PG8_BAR __builtin_amdgcn_s_barrier()
#define PG8_SCHED __builtin_amdgcn_sched_barrier(0)
#define PG8_GATHER(dst, un) do { _Pragma("unroll") for (int _i = 0; _i < 2; ++_i) _Pragma("unroll") for (int _h = 0; _h < 2; ++_h) dst[_h][_i] = (S.arow(un, _h * HALF + RA[_i]) * (unsigned)g.lda + (unsigned)CA[_i]) * 2u; } while (0)
    Unit cur, nxt; int ui = 0;
    if (!S.next(0, cur)) return;
    Acc acc;
#pragma unroll
    for (int a = 0; a < 2; ++a)
#pragma unroll
        for (int b = 0; b < 2; ++b)
#pragma unroll
            for (int m = 0; m < 4; ++m)
#pragma unroll
                for (int n = 0; n < 2; ++n) acc[a][b][m][n] = (f32x4){0.f, 0.f, 0.f, 0.f};
    bf16x8 At[4][2], B0[2][2], B1[2][2];
    if constexpr (Sched::GATHER) { PG8_GATHER(cvA, cur); }
    const char* cA = S.abase(g, cur); const char* cB = S.bbase(g, cur);
    PG8_STAGE(PG8_SB(0, 0), cB, voffB[0]); PG8_STAGE(PG8_SB(0, 1), cB, voffB[1]); PG8_STAGE(PG8_SA(0, 0), cA, cvA[0]); PG8_STAGE(PG8_SA(0, 1), cA, cvA[1]);
    if (wr == 1) PG8_BAR;
    PG8_WAIT_V(2); PG8_BAR;
    PG8_STAGE(PG8_SB(1, 0), cB + kstep, voffB[0]); PG8_STAGE(PG8_SA(1, 0), cA + kstep, cvA[0]); PG8_STAGE(PG8_SB(1, 1), cB + kstep, voffB[1]);
    PG8_WAIT_V(6); PG8_BAR;
    for (;;) {
        const bool has_next = S.next(ui + 1, nxt);
        if constexpr (Sched::GATHER) { if (has_next) { PG8_GATHER(nvA, nxt); } else {
#pragma unroll
            for (int i = 0; i < 2; ++i) { nvA[0][i] = cvA[0][i]; nvA[1][i] = cvA[1][i]; } } }
        const char* nA = has_next ? S.abase(g, nxt) : cA; const char* nB = has_next ? S.bbase(g, nxt) : cB;
#pragma unroll 1
        for (int t = 0; t < nt; t += 2) {
            const bool last = (t == nt - 2);
            const char* a1 = cA + (size_t)(t + 1) * kstep;
            const char* a2 = last ? nA : cA + (size_t)(t + 2) * kstep; const char* b2 = last ? nB : cB + (size_t)(t + 2) * kstep;
            const char* a3 = a2 + kstep; const char* b3 = b2 + kstep;
            unsigned wA[2][2];
#pragma unroll
            for (int i = 0; i < 2; ++i) { wA[0][i] = (Sched::GATHER && last) ? nvA[0][i] : cvA[0][i]; wA[1][i] = (Sched::GATHER && last) ? nvA[1][i] : cvA[1][i]; }
            PG8_LDB(B0, 0, 0); PG8_LDB(B1, 0, 1); PG8_SCHED; PG8_LDA(At, 0, 0); PG8_STAGE(PG8_SA(1, 1), a1, cvA[1]);
            PG8_WAIT_V(8); PG8_WAIT_L(0); PG8_BAR; PG8_MMA(0, 0, At, B0); PG8_MMA(0, 1, At, B1); PG8_BAR; PG8_SCHED;
            PG8_LDA(At, 0, 1); PG8_STAGE(PG8_SB(0, 0), b2, voffB[0]); PG8_STAGE(PG8_SB(0, 1), b2, voffB[1]); PG8_STAGE(PG8_SA(0, 0), a2, wA[0]);
            PG8_WAIT_V(8); PG8_WAIT_L(0); PG8_BAR; PG8_MMA(1, 0, At, B0); PG8_MMA(1, 1, At, B1); PG8_BAR; PG8_SCHED;
            PG8_LDB(B0, 1, 0); PG8_LDB(B1, 1, 1); PG8_SCHED; PG8_LDA(At, 1, 0); PG8_STAGE(PG8_SA(0, 1), a2, wA[1]);
            PG8_WAIT_V(8); PG8_WAIT_L(0); PG8_BAR; PG8_MMA(0, 0, At, B0); PG8_MMA(0, 1, At, B1); PG8_BAR; PG8_SCHED;
            PG8_LDA(At, 1, 1); PG8_STAGE(PG8_SB(1, 0), b3, voffB[0]); PG8_STAGE(PG8_SB(1, 1), b3, voffB[1]); PG8_STAGE(PG8_SA(1, 0), a3, wA[0]);
            PG8_WAIT_V(8); PG8_WAIT_L(0); PG8_BAR; PG8_MMA(1, 0, At, B0); PG8_MMA(1, 1, At, B1); PG8_BAR; PG8_SCHED;
        }
        if constexpr (ALIGN_EPI) { if (wr == 0) PG8_BAR; }
        E(acc, cur, wr, wc, fr, fq);
        if (!has_next) break;
#pragma unroll
        for (int a = 0; a < 2; ++a)
#pragma unroll
            for (int b = 0; b < 2; ++b)
#pragma unroll
                for (int m = 0; m < 4; ++m)
#pragma unroll
                    for (int n = 0; n < 2; ++n) acc[a][b][m][n] = (f32x4){0.f, 0.f, 0.f, 0.f};
        cur = nxt; cA = nA; cB = nB; ++ui;
#pragma unroll
        for (int i = 0; i < 2; ++i) { cvA[0][i] = nvA[0][i]; cvA[1][i] = nvA[1][i]; }
        if constexpr (ALIGN_EPI) { if (wr == 1) PG8_BAR; }
    }
    PG8_WAIT_V(0);
    if constexpr (!ALIGN_EPI) { if (wr == 0) PG8_BAR; }
    PG8_BAR;
#undef PG8_SA
#undef PG8_SB
#undef PG8_STAGE
#undef PG8_LDA
#undef PG8_LDB
#undef PG8_MMA
#undef PG8_WAIT_V
#undef PG8_WAIT_L
#undef PG8_BAR
#undef PG8_SCHED
#undef PG8_GATHER
}
}

namespace cg = cooperative_groups;
constexpr int LDS_BYTES = 152 * 1024, MISC_OFF = 147456;
struct MArgs { Params p; int lo, hi; };
constexpr int NPHASE = 16;

__device__ __forceinline__ void moe_build_tab(const Params& p, int l, PG8_LAS int* tab) {
    const int tid = fresh_tid();
    if (tid < 64) {
        const int n = tid < 32 ? ((const int*)(p.ws + WS_CTL))[l * 32 + tid] : 0; const int ntl = (n + 255) >> 8;
        int incl = ntl;
#pragma unroll
        for (int o = 1; o < 64; o <<= 1) { const int v = __shfl_up(incl, o); if (tid >= o) incl += v; }
        const int off = incl - ntl;
        if (tid < 32) { tab[1 + tid] = n; for (int j = 0; j < ntl; ++j) { tab[64 + off + j] = tid; tab[224 + off + j] = j * 256; } }
        if (tid == 31) tab[0] = incl;
    }
    __syncthreads();
}

__global__ void __launch_bounds__(512, 2) mega(MArgs a) {
    extern __shared__ __attribute__((aligned(16))) unsigned char lds_raw[];
    cg::grid_group grid = cg::this_grid();
    PG8_LAS unsigned char* lds = (PG8_LAS unsigned char*)lds_raw;
    PG8_LAS int* tab = (PG8_LAS int*)(lds + MISC_OFF);
    const Params& p = a.p; unsigned char* ws = p.ws;
    const int lo = a.lo, hi = a.hi, G = gridDim.x, bid = blockIdx.x;
    float* Z = p.out; float* X1 = (float*)(ws + WS_X1); float* X2 = (float*)(ws + WS_X2); const float* mod = (const float*)(ws + WS_MOD);
    bf16_t* H = (bf16_t*)(ws + WS_H);
#ifndef TESTPH
#define TESTPH -1
#endif
#define INC(c, k) ((TESTPH < 0 || TESTPH == (c)) && lo <= (k) && (k) < hi)
#define IN(k) INC(k, k)
#define SEAM(k) do { if (lo <= (k) && (k) + 1 < hi) grid.sync(); } while (0)
#define MOE_BLOCK(l, pb) { \
        const int* list = (const int*)(ws + WS_LIST) + (size_t)(l) * 32 * T; const float* wl = (const float*)(ws + WS_WL) + (size_t)(l) * 32 * T; \
        if (INC(5, (pb) + 5)) { phase_ln_router(p, (l), Z, X1, bid, G, (float*)lds_raw); __syncthreads(); } SEAM((pb) + 5); \
        if (INC(6, (pb) + 6)) { \
            moe_build_tab(p, (l), tab); \
            pg8::Gemm g{H, (const bf16_t*)(ws + WS_WGU) + (size_t)(l) * 32 * 512 * 1024, D, D, D}; \
            pg8::MoeOrder<true, 1> S{tab, list, (size_t)512 * 1024 * 2, G, bid}; \
            pg8::EpiMoe1 E{tab, wl, (bf16_t*)(ws + WS_RA + RA_ACT)}; \
            pg8::gemm_phase<pg8::EpiMoe1, pg8::MoeOrder<true, 1>, true>(lds, g, S, E); \
        } SEAM((pb) + 6); \
        if (INC(7, (pb) + 7)) { \
            moe_build_tab(p, (l), tab); \
            pg8::Gemm g{(const bf16_t*)(ws + WS_RA + RA_ACT), (const bf16_t*)(ws + WS_WD) + (size_t)(l) * 32 * 1024 * 256, EFF, EFF, EFF}; \
            pg8::MoeOrder<false, 2> S{tab, list, (size_t)1024 * 256 * 2, G, bid}; \
            pg8::EpiMoe2 E{tab, list, (bf16_t*)(ws + WS_RA + RA_Y2)}; \
            pg8::gemm_phase<pg8::EpiMoe2, pg8::MoeOrder<false, 2>, true>(lds, g, S, E); \
        } SEAM((pb) + 7); \
        if (INC(8, (pb) + 8)) { phase_ln2(p, (l), X1, (l) == 0 ? X2 : p.out, (l) == 0 ? 1 : -1, bid, G); } SEAM((pb) + 8); }
    if (IN(0)) { p0_prologue(p, bid, G, (float*)lds_raw); } SEAM(0);
    if (IN(1)) { phase_h0(p, bid, G); } SEAM(1);
    if (IN(2)) {
        pg8::Gemm g{H, (const bf16_t*)(ws + WS_WQKV), D, D, D}; pg8::StaticOrder S; S.init(T, NQKV, G, bid);
        pg8::EpiQKV E{p.in[8], (const float*)(ws + WS_ROPE_C), (const float*)(ws + WS_ROPE_S), (bf16_t*)(ws + WS_RA + RA_Q), (bf16_t*)(ws + WS_RA + RA_K), (bf16_t*)(ws + WS_RA + RA_V)};
        pg8::gemm_phase<pg8::EpiQKV, pg8::StaticOrder, true>(lds, g, S, E);
    } SEAM(2);
    SEAM(3);
    if (IN(4)) {
        pg8::Gemm g{(const bf16_t*)(ws + WS_RA + RA_O), (const bf16_t*)(ws + WS_WO), D, D, D}; pg8::StaticOrder S; S.init(T, D, G, bid);
        pg8::EpiResid E{p.in[0], p.in[11], mod + 2 * 1024, Z};
        pg8::gemm_phase<pg8::EpiResid, pg8::StaticOrder, true>(lds, g, S, E);
    } SEAM(4);
    MOE_BLOCK(0, 0)
    if (IN(9)) {
        pg8::Gemm g{H, (const bf16_t*)(ws + WS_WIN), D, D, D}; pg8::StaticOrder S; S.init(T, 2 * GW, G, bid);
        pg8::EpiGeluUV E{p.in[13], (bf16_t*)(ws + WS_RA + RA_U), (bf16_t*)(ws + WS_RA + RA_V2), (float*)(ws + WS_VSTAT)};
        pg8::gemm_phase<pg8::EpiGeluUV, pg8::StaticOrder, true>(lds, g, S, E);
    } SEAM(9);
    SEAM(10);
    if (IN(11)) {
        pg8::Gemm g{(const bf16_t*)(ws + WS_RA + RA_GATED), (const bf16_t*)(ws + WS_WOUT), GW, GW, GW}; pg8::StaticOrder S; S.init(T, D, G, bid);
        pg8::EpiResid E{X2, p.in[19], mod + 2 * 6144 + 2 * 1024, Z};
        pg8::gemm_phase<pg8::EpiResid, pg8::StaticOrder, true>(lds, g, S, E);
    } SEAM(11);
    MOE_BLOCK(1, 7)
#undef IN
#undef SEAM
#undef MOE_BLOCK
}

static const bool FAST[NPHASE] = {1, 1, 1, 0, 1, 1, 1, 1, 1, 1, 0, 1, 1, 1, 1, 1};

extern "C" void kernel_launch(void* const* d_in, const int* in_sizes, int n_in, void* d_out, int out_size, void* d_ws, size_t ws_size, hipStream_t stream) {
    if (n_in != 26 || out_size != T * D || ws_size < WS_END) { fprintf(stderr, "kernel_launch: unexpected problem (n_in %d out %d ws %zu)\n", n_in, out_size, ws_size); return; }
    static int grid = 0;
    if (!grid) {
        (void)hipFuncSetAttribute((const void*)k_ln_router, hipFuncAttributeMaxDynamicSharedMemorySize, 36 * 1024 * 4);
        (void)hipFuncSetAttribute((const void*)mega, hipFuncAttributeMaxDynamicSharedMemorySize, LDS_BYTES);
        int dev = 0, cus = 0, per_cu = 0;
        (void)hipGetDevice(&dev); (void)hipDeviceGetAttribute(&cus, hipDeviceAttributeMultiprocessorCount, dev);
        (void)hipOccupancyMaxActiveBlocksPerMultiprocessor(&per_cu, (const void*)mega, 512, LDS_BYTES);
        if (per_cu < 1) { fprintf(stderr, "kernel_launch: occupancy query says %d blocks per CU\n", per_cu); per_cu = 1; }
        grid = cus;
        fprintf(stderr, "kernel_launch: cus %d per_cu %d grid %d\n", cus, per_cu, grid);
    }
    Params p{};
    for (int i = 0; i < 26; ++i) p.in[i] = (const float*)d_in[i];
    p.out = (float*)d_out; p.ws = (unsigned char*)d_ws;
    unsigned char* ws = p.ws;
    float* Z = p.out; float* X1 = (float*)(ws + WS_X1); float* X2 = (float*)(ws + WS_X2); const float* mod = (const float*)(ws + WS_MOD);
    bf16_t* H = (bf16_t*)(ws + WS_H);
    const int* rowmap = (const int*)(ws + WS_TAB); const int* te = (const int*)(ws + WS_TAB) + 2 * MPAD;
    int k = 0;
    while (k < NPHASE) {
        if (FAST[k]) {
            int e = k; while (e < NPHASE && FAST[e]) ++e;
            MArgs ma{p, k, e}; void* args[] = {&ma};
            const hipError_t err = hipLaunchCooperativeKernel((const void*)mega, dim3(grid), dim3(512), args, LDS_BYTES, stream);
            if (err != hipSuccess) fprintf(stderr, "kernel_launch: cooperative launch [%d,%d) failed: %s\n", k, e, hipGetErrorString(err));
            k = e; continue;
        }
        const int l = k >= 9 ? 1 : 0; const int ph = (k >= 12) ? k - 7 : k;
        const int* nt = (const int*)(ws + WS_CTL) + 64 + l;
        switch (ph) {
        case 0: hipLaunchKernelGGL(k_prologue, dim3(256), dim3(512), 0, stream, p); break;
        case 1: hipLaunchKernelGGL(k_h0, dim3(256), dim3(512), 0, stream, p); break;
        case 2: { NG g{H, nullptr, (const bf16_t*)(ws + WS_WQKV), nullptr, nullptr, 0, D, D, D, 0};
            hipLaunchKernelGGL(ngemm<NEpiF32>, dim3(NQKV / 64, T / 64), dim3(256), 0, stream, g, NEpiF32{(float*)(ws + WS_RA + RA_QKVRAW), NQKV, 0});
            hipLaunchKernelGGL(k_rope_post, dim3(T * 768 / 256), dim3(256), 0, stream, p); } break;
        case 3: hipLaunchKernelGGL(k_attn_naive, dim3(T * 16 / 4), dim3(256), 0, stream, p); break;
        case 4: { NG g2{(const bf16_t*)(ws + WS_RA + RA_O), nullptr, (const bf16_t*)(ws + WS_WO), nullptr, nullptr, 0, D, D, D, 0};
            hipLaunchKernelGGL(ngemm<NEpiResid>, dim3(D / 64, T / 64), dim3(256), 0, stream, g2, NEpiResid{p.in[0], p.in[11], mod + 2 * 1024, Z}); } break;
        case 5: hipLaunchKernelGGL(k_ln_router, dim3(256), dim3(512), 36 * 1024 * 4, stream, KA{p, (const float*)Z, X1, l, 0}); break;
        case 6: { hipLaunchKernelGGL(k_moe_prep, dim3(1), dim3(256), 0, stream, KA{p, nullptr, nullptr, l, 0});
            NG g3{H, rowmap, (const bf16_t*)(ws + WS_WGU) + (size_t)l * 32 * 512 * 1024, te, nt, (size_t)512 * 1024, D, D, D, 0};
            hipLaunchKernelGGL(ngemm<NEpiF32>, dim3(512 / 64, MPAD / 64), dim3(256), 0, stream, g3, NEpiF32{(float*)(ws + WS_RA + RA_GURAW), 512, 0});
            hipLaunchKernelGGL(k_moe1_post, dim3(MPAD), dim3(256), 0, stream, KA{p, nullptr, nullptr, l, 0}); } break;
        case 7: { hipLaunchKernelGGL(k_moe_prep, dim3(1), dim3(256), 0, stream, KA{p, nullptr, nullptr, l, 0});
            NG g4{(const bf16_t*)(ws + WS_RA + RA_ACT), nullptr, (const bf16_t*)(ws + WS_WD) + (size_t)l * 32 * 1024 * 256, te, nt, (size_t)1024 * 256, EFF, EFF, EFF, 0};
            hipLaunchKernelGGL(ngemm<NEpiMoe2>, dim3(D / 64, MPAD / 64), dim3(256), 0, stream, g4, NEpiMoe2{rowmap, (bf16_t*)(ws + WS_RA + RA_Y2)}); } break;
        case 8: hipLaunchKernelGGL(k_ln2, dim3(256), dim3(512), 0, stream, KA{p, (const float*)X1, l == 0 ? X2 : p.out, l, l == 0 ? 1 : -1}); break;
        case 9: { NG g{H, nullptr, (const bf16_t*)(ws + WS_WIN), nullptr, nullptr, 0, D, D, D, 0};
            hipLaunchKernelGGL(ngemm<NEpiGelu>, dim3(4096 / 64, T / 64), dim3(256), 0, stream, g, NEpiGelu{p.in[13], (bf16_t*)(ws + WS_RA + RA_U), (bf16_t*)(ws + WS_RA + RA_V2)});
            hipLaunchKernelGGL(k_vstat_naive, dim3(T / 4), dim3(256), 0, stream, p); } break;
        case 10: { if (FAST[9]) hipLaunchKernelGGL(k_vstat_bridge, dim3(T / 256), dim3(256), 0, stream, p);
            hipLaunchKernelGGL(k_gate_naive, dim3(T * GW / 256), dim3(256), 0, stream, p); } break;
        case 11: { NG g2{(const bf16_t*)(ws + WS_RA + RA_GATED), nullptr, (const bf16_t*)(ws + WS_WOUT), nullptr, nullptr, 0, GW, GW, GW, 0};
            hipLaunchKernelGGL(ngemm<NEpiResid>, dim3(D / 64, T / 64), dim3(256), 0, stream, g2, NEpiResid{X2, p.in[19], mod + 2 * 6144 + 2 * 1024, Z}); } break;
        }
        ++k;
    }
}
```

```cpp
#include <hip/hip_runtime.h>
#include <hip/hip_cooperative_groups.h>
#include <cstdio>
#include <cstdint>

typedef unsigned short bf16_t;
typedef unsigned u32x4 __attribute__((ext_vector_type(4)));
typedef unsigned u32x2 __attribute__((ext_vector_type(2)));
typedef float f32x4 __attribute__((ext_vector_type(4)));
typedef float f32x2v __attribute__((ext_vector_type(2)));

constexpr int T = 16384, D = 1024, SEQ = 8192;
constexpr int NQKV = 1536, GW = 2048  , NEXP = 32, EFF = 256;
constexpr float LN_EPS = 1e-5f, ALPHA = 1.4142135623730951f;
constexpr float QSCALE = 0.125f * 1.4426950408889634f;
constexpr float LOG2E = 1.4426950408889634f;
constexpr int MAXTILES = 160, MPAD = MAXTILES * 256;

constexpr size_t MiB = 1u << 20;
constexpr size_t WS_CTL = 0;
constexpr size_t WS_MOD = 64 * 1024;
constexpr size_t WS_ROPE_C = 1 * MiB, WS_ROPE_S = 3 * MiB;
constexpr size_t WS_WS = 5 * MiB;
constexpr size_t WS_VSTAT = 6 * MiB;
constexpr size_t WS_LIST = 10 * MiB;
constexpr size_t WS_WL = 14 * MiB;
constexpr size_t WS_TAB = 18 * MiB;
constexpr size_t WS_ROWSTAT = 19 * MiB;
constexpr size_t WS_WQKV = 20 * MiB, WS_WO = 23 * MiB, WS_WIN = 25 * MiB, WS_WOUT = 33 * MiB, WS_WGU = 37 * MiB, WS_WD = 101 * MiB;
constexpr size_t WS_H = 133 * MiB, WS_X1 = 165 * MiB, WS_X2 = 229 * MiB, WS_RA = 293 * MiB, WS_END = 485 * MiB;
constexpr size_t RA_Q = 0, RA_K = 32 * MiB, RA_V = 40 * MiB, RA_O = 48 * MiB, RA_QKVRAW = 80 * MiB;
constexpr size_t RA_U = 0, RA_V2 = 64 * MiB, RA_GATED = 128 * MiB;
constexpr size_t RA_Y2 = 0, RA_ACT = 64 * MiB, RA_GURAW = 84 * MiB;

struct Params {
    const float* in[26];
    float* out;
    unsigned char* ws;
};
struct KA { Params p; const float* a; float* b; int i0, i1; };

__device__ __forceinline__ unsigned f2bf(float f) { unsigned u = __builtin_bit_cast(unsigned, f); return (u + 0x7fffu + ((u >> 16) & 1u)) >> 16; }
__device__ __forceinline__ unsigned pk2(float lo, float hi) { return f2bf(lo) | (f2bf(hi) << 16); }
__device__ __forceinline__ float bf2f(bf16_t v) { return __builtin_bit_cast(float, (unsigned)v << 16); }
__device__ __forceinline__ float wave_sum(float v) {
#pragma unroll
    for (int o = 1; o < 64; o <<= 1) v += __shfl_xor(v, o);
    return v;
}
__device__ __forceinline__ float wave_max(float v) {
#pragma unroll
    for (int o = 1; o < 64; o <<= 1) v = fmaxf(v, __shfl_xor(v, o));
    return v;
}
__device__ __forceinline__ float silu_f(float v) { return v / (1.f + expf(-v)); }

__device__ __forceinline__ int slot_qkv(int n) {
    int tile, hl, d;
    if (n < 1024) { const int head = n >> 6; d = n & 63; tile = head >> 2; hl = head & 3; }
    else if (n < 1280) { const int m = n - 1024; tile = 4; hl = m >> 6; d = m & 63; }
    else { const int m = n - 1280; tile = 5; hl = m >> 6; d = m & 63; }
    return tile * 256 + (d >> 5) * 128 + hl * 32 + (d & 31);
}
__device__ __forceinline__ int slot_gu(int n) {
    const int up = n >> 8, c = n & 255, pn = c >> 7; return pn * 256 + up * 128 + (c & 127);
}

__device__ __forceinline__ int fresh_tid() { int t = threadIdx.x; asm volatile("" : "+v"(t)); return t; }

__device__ __forceinline__ void mods_item(int tid, int item, const float* c, const float* ada_w, const float* ada_b, float* mod, float* lds) {
    const int wave = tid >> 6, lane = tid & 63;
    const int l = item / 96, cg = item % 96;
    const float* W = ada_w + (size_t)l * 1024 * 6144 + cg * 64 + lane;
    float a0 = 0.f, a1 = 0.f;
    const int kb = wave * 128;
#pragma unroll 8
    for (int k = 0; k < 128; ++k) {
        const float w = W[(size_t)(kb + k) * 6144];
        a0 += silu_f(c[kb + k]) * w; a1 += silu_f(c[1024 + kb + k]) * w;
    }
    lds[(wave * 2 + 0) * 64 + lane] = a0; lds[(wave * 2 + 1) * 64 + lane] = a1;
    __syncthreads();
    if (tid < 128) { const int b = tid >> 6; float s = 0.f;
#pragma unroll
        for (int w = 0; w < 8; ++w) s += lds[(w * 2 + b) * 64 + lane];
        mod[(size_t)(l * 2 + b) * 6144 + cg * 64 + lane] = s + ada_b[l * 6144 + cg * 64 + lane]; }
    __syncthreads();
}
__device__ __forceinline__ void conv_item(const float* src, int K, int N, bf16_t* dst, int map, int item, int lane) {
    const int nblk = N >> 6, kb = item / nblk, nb = item % nblk, k0 = kb * 32, n = nb * 64 + lane;
    const float* s = src + (size_t)k0 * N + n;
    float v[32];
#pragma unroll
    for (int t = 0; t < 32; ++t) v[t] = s[(size_t)t * N];
    const int slot = map == 1 ? slot_qkv(n) : (map == 2 ? slot_gu(n) : n);
    u32x4* d = (u32x4*)(dst + (size_t)slot * K + k0);
#pragma unroll
    for (int j = 0; j < 4; ++j) { u32x4 o; o.x = pk2(v[8 * j], v[8 * j + 1]); o.y = pk2(v[8 * j + 2], v[8 * j + 3]); o.z = pk2(v[8 * j + 4], v[8 * j + 5]); o.w = pk2(v[8 * j + 6], v[8 * j + 7]); d[j] = o; }
}
constexpr int CI_QKV = 32 * 24, CI_WO = 32 * 16, CI_WIN = 32 * 64, CI_WOUT = 64 * 16, CI_GU1 = 32 * 8, CI_GU = 64 * CI_GU1, CI_DN1 = 8 * 16, CI_DN = 64 * CI_DN1;
constexpr int CI_TOTAL = CI_QKV + CI_WO + CI_WIN + CI_WOUT + CI_GU + CI_DN;

__device__ __forceinline__ void p0_prologue(const Params& p, int wg, int nwg, float* lds) {
    const int tid = fresh_tid(), wave = tid >> 6, lane = tid & 63;
    unsigned char* ws = p.ws;
    if (wg == 0 && tid < 128) ((int*)(ws + WS_CTL))[tid] = 0;
    for (int it = wg; it < 192; it += nwg) mods_item(tid, it, p.in[1], p.in[3], p.in[4], (float*)(ws + WS_MOD), lds);
    const int gw = wg * 8 + wave, ngw = nwg * 8;
    for (int it = gw; it < CI_TOTAL; it += ngw) {
        int r = it;
        if (r < CI_QKV) { conv_item(p.in[7], 1024, 1536, (bf16_t*)(ws + WS_WQKV), 1, r, lane); continue; } r -= CI_QKV;
        if (r < CI_WO) { conv_item(p.in[10], 1024, 1024, (bf16_t*)(ws + WS_WO), 0, r, lane); continue; } r -= CI_WO;
        if (r < CI_WIN) { conv_item(p.in[12], 1024, 4096, (bf16_t*)(ws + WS_WIN), 0, r, lane); continue; } r -= CI_WIN;
        if (r < CI_WOUT) { conv_item(p.in[18], 2048, 1024, (bf16_t*)(ws + WS_WOUT), 0, r, lane); continue; } r -= CI_WOUT;
        if (r < CI_GU) { const int mtx = r / CI_GU1; conv_item(p.in[24] + (size_t)mtx * 1024 * 512, 1024, 512, (bf16_t*)(ws + WS_WGU) + (size_t)mtx * 512 * 1024, 2, r % CI_GU1, lane); continue; } r -= CI_GU;
        { const int mtx = r / CI_DN1; conv_item(p.in[25] + (size_t)mtx * 256 * 1024, 256, 1024, (bf16_t*)(ws + WS_WD) + (size_t)mtx * 1024 * 256, 0, r % CI_DN1, lane); }
    }
    const int gt = wg * 512 + tid, ngt = nwg * 512;
    for (int i = gt; i < 8 * 128 * 128; i += ngt) { const int t = (i >> 7) & 127, s = i & 127; ((bf16_t*)(ws + WS_WS))[i] = (bf16_t)f2bf(s <= t ? p.in[16][i] : 0.f); }
    const int* pos = (const int*)p.in[2];
    for (int i = gt; i < T * 32; i += ngt) {
        const int row = i >> 5, j = i & 31;
        double f = 1.0;
        for (int q = 0; q < j; ++q) f *= 0.7498942093324558;
        const double rev = (double)pos[row] * f * 0.15915494309189535;
        const float fr = (float)(rev - floor(rev));
        ((float*)(ws + WS_ROPE_C))[i] = __builtin_amdgcn_cosf(fr);
        ((float*)(ws + WS_ROPE_S))[i] = __builtin_amdgcn_sinf(fr);
    }
}

__device__ __forceinline__ void phase_h0(const Params& p, int wg, int nwg) {
    const int tid = fresh_tid(), lane = tid & 63, gw = wg * 8 + (tid >> 6), ngw = nwg * 8;
    const float* x = p.in[0]; const float* mod = (const float*)(p.ws + WS_MOD); bf16_t* H = (bf16_t*)(p.ws + WS_H);
    for (int row = gw; row < T; row += ngw) {
        const int b = row >> 13; const float* sh = mod + (size_t)(0 * 2 + b) * 6144; const float* sc = sh + 1024;
#pragma unroll
        for (int j = 0; j < 4; ++j) { const int col = 4 * lane + 256 * j;
            const f32x4 xv = *(const f32x4*)(x + (size_t)row * D + col), s = *(const f32x4*)(sc + col), h = *(const f32x4*)(sh + col);
            const f32x4 o = xv * (s + 1.0f) + h; u32x2 w; w.x = pk2(o.x, o.y); w.y = pk2(o.z, o.w); *(u32x2*)(H + (size_t)row * D + col) = w; }
    }
}
__device__ __forceinline__ void phase_ln_router(const Params& p, int l, const float* z, float* xo, int wg, int nwg, float* lds) {
    const int tid = fresh_tid(), wave = tid >> 6, lane = tid & 63;
    const float* wgr = p.in[20] + (size_t)l * 1024 * 4; const float* bgr = p.in[21] + l * 4;
    const float* wer = p.in[22] + (size_t)l * 1024 * 32; const float* ber = p.in[23] + l * 32;
#pragma unroll 1
    for (int o = 0; o < 36; ++o)
        for (int k = tid; k < 1024; k += 512) lds[o * 1024 + k] = o < 4 ? wgr[k * 4 + o] : wer[k * 32 + (o - 4)];
    __syncthreads();
    const float* lg = p.in[5] + (size_t)(l * 2 + 0) * D; const float* lb = p.in[6] + (size_t)(l * 2 + 0) * D;
    const float* mod = (const float*)(p.ws + WS_MOD); bf16_t* H = (bf16_t*)(p.ws + WS_H);
    int* cnt = (int*)(p.ws + WS_CTL) + l * 32; int* list = (int*)(p.ws + WS_LIST) + (size_t)l * 32 * T; float* wl = (float*)(p.ws + WS_WL) + (size_t)l * 32 * T;
    const int gw = wg * 8 + wave, ngw = nwg * 8;
#pragma unroll 1
    for (int row = gw; row < T; row += ngw) {
        const int b = row >> 13; const float* sh = mod + (size_t)(l * 2 + b) * 6144 + 3 * 1024; const float* sc = sh + 1024;
        f32x4 v[4]; float s = 0.f;
#pragma unroll
        for (int j = 0; j < 4; ++j) { v[j] = *(const f32x4*)(z + (size_t)row * D + 4 * lane + 256 * j); s += (v[j].x + v[j].y) + (v[j].z + v[j].w); }
        const float mean = wave_sum(s) * (1.f / D); float s2 = 0.f;
#pragma unroll
        for (int j = 0; j < 4; ++j) { v[j] = v[j] - mean; s2 += (v[j].x * v[j].x + v[j].y * v[j].y) + (v[j].z * v[j].z + v[j].w * v[j].w); }
        const float rstd = 1.f / sqrtf(wave_sum(s2) * (1.f / D) + LN_EPS);
        f32x4 h[4];
#pragma unroll
        for (int j = 0; j < 4; ++j) { const int col = 4 * lane + 256 * j;
            const f32x4 x1 = v[j] * rstd * *(const f32x4*)(lg + col) + *(const f32x4*)(lb + col);
            *(f32x4*)(xo + (size_t)row * D + col) = x1;
            h[j] = x1 * (*(const f32x4*)(sc + col) + 1.0f) + *(const f32x4*)(sh + col);
            u32x2 w; w.x = pk2(h[j].x, h[j].y); w.y = pk2(h[j].z, h[j].w); *(u32x2*)(H + (size_t)row * D + col) = w; }
        float gl[4];
#pragma unroll
        for (int o = 0; o < 4; ++o) { float a = 0.f;
#pragma unroll
            for (int j = 0; j < 4; ++j) { const f32x4 w = *(const f32x4*)(lds + o * 1024 + 4 * lane + 256 * j); a += (h[j].x * w.x + h[j].y * w.y) + (h[j].z * w.z + h[j].w * w.w); }
            gl[o] = wave_sum(a) + bgr[o]; }
        int g = 0; float gm = gl[0];
#pragma unroll
        for (int o = 1; o < 4; ++o) if (gl[o] > gm) { gm = gl[o]; g = o; }
        float gs = 0.f;
#pragma unroll
        for (int o = 0; o < 4; ++o) gs += expf(gl[o] - gm);
        const float gp = 1.f / gs;
        g = __builtin_amdgcn_readfirstlane(g);
        float v0 = -INFINITY, v1 = -INFINITY; int e0 = 0, e1 = 0;
#pragma unroll 2
        for (int e = 0; e < 8; ++e) { float a = 0.f; const float* wrow = lds + (4 + g * 8 + e) * 1024;
#pragma unroll
            for (int j = 0; j < 4; ++j) { const f32x4 w = *(const f32x4*)(wrow + 4 * lane + 256 * j); a += (h[j].x * w.x + h[j].y * w.y) + (h[j].z * w.z + h[j].w * w.w); }
            const float val = wave_sum(a) + ber[g * 8 + e];
            if (val > v0) { v1 = v0; e1 = e0; v0 = val; e0 = e; } else if (val > v1) { v1 = val; e1 = e; } }
        const float w0 = 1.f / (1.f + expf(v1 - v0)), w1 = 1.f - w0;
        if (lane == 0) {
            const int ea = g * 8 + e0, eb = g * 8 + e1;
            const int pa = atomicAdd(cnt + ea, 1); list[(size_t)ea * T + pa] = row * 2 + 0; wl[(size_t)ea * T + pa] = w0 * gp;
            const int pb = atomicAdd(cnt + eb, 1); list[(size_t)eb * T + pb] = row * 2 + 1; wl[(size_t)eb * T + pb] = w1 * gp;
        }
    }
}
__device__ __forceinline__ void phase_ln2(const Params& p, int l, const float* x1, float* xo, int nextl, int wg, int nwg) {
    const int tid = fresh_tid(), lane = tid & 63, gw = wg * 8 + (tid >> 6), ngw = nwg * 8;
    const float* lg = p.in[5] + (size_t)(l * 2 + 1) * D; const float* lb = p.in[6] + (size_t)(l * 2 + 1) * D;
    const float* mod = (const float*)(p.ws + WS_MOD); bf16_t* H = (bf16_t*)(p.ws + WS_H); const bf16_t* y2 = (const bf16_t*)(p.ws + WS_RA + RA_Y2);
    for (int row = gw; row < T; row += ngw) {
        const int b = row >> 13; const float* gt = mod + (size_t)(l * 2 + b) * 6144 + 5 * 1024;
        f32x4 v[4]; float s = 0.f;
#pragma unroll
        for (int j = 0; j < 4; ++j) { const int col = 4 * lane + 256 * j;
            const f32x4 xv = *(const f32x4*)(x1 + (size_t)row * D + col), g = *(const f32x4*)(gt + col);
            const u32x2 ya = *(const u32x2*)(y2 + ((size_t)row * 2 + 0) * D + col), yb = *(const u32x2*)(y2 + ((size_t)row * 2 + 1) * D + col);
            f32x4 y; y.x = __builtin_bit_cast(float, ya.x << 16) + __builtin_bit_cast(float, yb.x << 16); y.y = __builtin_bit_cast(float, ya.x & 0xffff0000u) + __builtin_bit_cast(float, yb.x & 0xffff0000u);
            y.z = __builtin_bit_cast(float, ya.y << 16) + __builtin_bit_cast(float, yb.y << 16); y.w = __builtin_bit_cast(float, ya.y & 0xffff0000u) + __builtin_bit_cast(float, yb.y & 0xffff0000u);
            v[j] = xv * ALPHA + (g + 1.0f) * y; s += (v[j].x + v[j].y) + (v[j].z + v[j].w); }
        const float mean = wave_sum(s) * (1.f / D); float s2 = 0.f;
#pragma unroll
        for (int j = 0; j < 4; ++j) { v[j] = v[j] - mean; s2 += (v[j].x * v[j].x + v[j].y * v[j].y) + (v[j].z * v[j].z + v[j].w * v[j].w); }
        const float rstd = 1.f / sqrtf(wave_sum(s2) * (1.f / D) + LN_EPS);
        const float* sh = mod + (size_t)((nextl < 0 ? 0 : nextl) * 2 + b) * 6144; const float* sc = sh + 1024;
#pragma unroll
        for (int j = 0; j < 4; ++j) { const int col = 4 * lane + 256 * j;
            const f32x4 x2 = v[j] * rstd * *(const f32x4*)(lg + col) + *(const f32x4*)(lb + col);
            *(f32x4*)(xo + (size_t)row * D + col) = x2;
            if (nextl >= 0) { const f32x4 h = x2 * (*(const f32x4*)(sc + col) + 1.0f) + *(const f32x4*)(sh + col);
                u32x2 w; w.x = pk2(h.x, h.y); w.y = pk2(h.z, h.w); *(u32x2*)(H + (size_t)row * D + col) = w; } }
    }
}

__global__ void __launch_bounds__(512) k_prologue(Params p) { __shared__ float lds[1024]; p0_prologue(p, blockIdx.x, gridDim.x, lds); }
__global__ void __launch_bounds__(512) k_h0(Params p) { phase_h0(p, blockIdx.x, gridDim.x); }
__global__ void __launch_bounds__(512) k_ln_router(KA a) { extern __shared__ float dl[]; phase_ln_router(a.p, a.i0, a.a, a.b, blockIdx.x, gridDim.x, dl); }
__global__ void __launch_bounds__(512) k_ln2(KA a) { phase_ln2(a.p, a.i0, a.a, a.b, a.i1, blockIdx.x, gridDim.x); }

struct NG { const bf16_t* A; const int* rowmap; const bf16_t* Bt; const int* tile_expert; const int* ntiles; size_t estride; int lda, ldb, K, pad; };
template <class Epi> __global__ void __launch_bounds__(256) ngemm(NG g, Epi E) {
    __shared__ float As[16][68], Bs[16][68];
    const int tid = threadIdx.x, tx = tid & 15, ty = tid >> 4;
    const int m0 = blockIdx.y * 64, n0 = blockIdx.x * 64;
    const bf16_t* Bt = g.Bt;
    if (g.tile_expert) { if ((m0 >> 8) >= *g.ntiles) return; Bt += (size_t)g.tile_expert[m0 >> 8] * g.estride; }
    const int lr = tid >> 2, kq = tid & 3;
    int arow = m0 + lr; if (g.rowmap) { const int rm = g.rowmap[arow]; arow = rm < 0 ? 0 : (rm >> 1); }
    const bf16_t* ap = g.A + (size_t)arow * g.lda + kq * 4; const bf16_t* bp = Bt + (size_t)(n0 + lr) * g.ldb + kq * 4;
    float acc[4][4];
#pragma unroll
    for (int i = 0; i < 4; ++i)
#pragma unroll
        for (int j = 0; j < 4; ++j) acc[i][j] = 0.f;
    for (int k0 = 0; k0 < g.K; k0 += 16) {
        const u32x2 av = *(const u32x2*)(ap + k0), bv = *(const u32x2*)(bp + k0);
        __syncthreads();
        As[kq * 4 + 0][lr] = __builtin_bit_cast(float, av.x << 16); As[kq * 4 + 1][lr] = __builtin_bit_cast(float, av.x & 0xffff0000u);
        As[kq * 4 + 2][lr] = __builtin_bit_cast(float, av.y << 16); As[kq * 4 + 3][lr] = __builtin_bit_cast(float, av.y & 0xffff0000u);
        Bs[kq * 4 + 0][lr] = __builtin_bit_cast(float, bv.x << 16); Bs[kq * 4 + 1][lr] = __builtin_bit_cast(float, bv.x & 0xffff0000u);
        Bs[kq * 4 + 2][lr] = __builtin_bit_cast(float, bv.y << 16); Bs[kq * 4 + 3][lr] = __builtin_bit_cast(float, bv.y & 0xffff0000u);
        __syncthreads();
#pragma unroll
        for (int k = 0; k < 16; ++k) {
            const f32x4 a = *(const f32x4*)&As[k][ty * 4], b = *(const f32x4*)&Bs[k][tx * 4];
#pragma unroll
            for (int i = 0; i < 4; ++i)
#pragma unroll
                for (int j = 0; j < 4; ++j) acc[i][j] += a[i] * b[j];
        }
    }
#pragma unroll
    for (int i = 0; i < 4; ++i)
#pragma unroll
        for (int j = 0; j < 4; ++j) E(m0 + ty * 4 + i, n0 + tx * 4 + j, acc[i][j]);
}
struct NEpiF32 { float* C; int ldc, pad; __device__ void operator()(int r, int c, float v) const { C[(size_t)r * ldc + c] = v; } };
struct NEpiResid { const float* x; const float* bias; const float* gt  ; float* z;
    __device__ void operator()(int r, int c, float v) const { const int b = r >> 13; z[(size_t)r * D + c] = ALPHA * x[(size_t)r * D + c] + (1.f + gt[b * 6144 + c]) * (v + bias[c]); } };
struct NEpiGelu { const float* bias; bf16_t* U; bf16_t* V;
    __device__ void operator()(int r, int c, float v) const { const float a = v + bias[c]; const float g = 0.5f * a * (1.f + erff(a * 0.70710678118654752f));
        if (c < GW) U[(size_t)r * GW + c] = (bf16_t)f2bf(g); else V[(size_t)r * GW + c - GW] = (bf16_t)f2bf(g); } };
struct NEpiMoe2 { const int* rowmap; bf16_t* y2; __device__ void operator()(int r, int c, float v) const { const int rm = rowmap[r]; if (rm >= 0) y2[(size_t)rm * D + c] = (bf16_t)f2bf(v); } };

__global__ void k_rope_post(Params p) {
    const size_t i = (size_t)blockIdx.x * 256 + threadIdx.x; if (i >= (size_t)T * 768) return;
    const int row = (int)(i / 768), q = (int)(i % 768);
    const int tile = q / 128, hl = (q % 128) / 32, dp = q % 32;
    const float* raw = (const float*)(p.ws + WS_RA + RA_QKVRAW) + (size_t)row * NQKV + tile * 256;
    const float* bq = p.in[8];
    int scol; bf16_t* dst; float sc = 1.f; int ld;
    if (tile < 4) { scol = (tile * 4 + hl) * 64; dst = (bf16_t*)(p.ws + WS_RA + RA_Q) + (size_t)row * 1024 + scol; sc = QSCALE; }
    else if (tile == 4) { scol = 1024 + hl * 64; dst = (bf16_t*)(p.ws + WS_RA + RA_K) + (size_t)row * 256 + hl * 64; }
    else { scol = 1280 + hl * 64; dst = (bf16_t*)(p.ws + WS_RA + RA_V) + (size_t)row * 256 + hl * 64; }
    const float x1 = raw[hl * 32 + dp] + bq[scol + dp], x2 = raw[128 + hl * 32 + dp] + bq[scol + 32 + dp];
    float o1 = x1, o2 = x2;
    if (tile < 5) { const float cs = ((const float*)(p.ws + WS_ROPE_C))[(size_t)row * 32 + dp], sn = ((const float*)(p.ws + WS_ROPE_S))[(size_t)row * 32 + dp];
        o1 = x1 * cs - x2 * sn; o2 = x2 * cs + x1 * sn; }
    dst[dp] = (bf16_t)f2bf(o1 * sc); dst[32 + dp] = (bf16_t)f2bf(o2 * sc);
    (void)ld;
}
__global__ void __launch_bounds__(256) k_attn_naive(Params p) {
    const int w = blockIdx.x * 4 + (threadIdx.x >> 6), lane = threadIdx.x & 63;
    const int row = w >> 4, hq = w & 15, kvh = hq >> 2, s = row & (SEQ - 1);
    const bf16_t* Q = (const bf16_t*)(p.ws + WS_RA + RA_Q) + (size_t)row * 1024 + hq * 64;
    const bf16_t* Kb = (const bf16_t*)(p.ws + WS_RA + RA_K); const bf16_t* Vb = (const bf16_t*)(p.ws + WS_RA + RA_V);
    float q[64];
#pragma unroll
    for (int i = 0; i < 8; ++i) { const u32x4 v = *(const u32x4*)(Q + i * 8);
        q[8 * i] = __builtin_bit_cast(float, v.x << 16); q[8 * i + 1] = __builtin_bit_cast(float, v.x & 0xffff0000u); q[8 * i + 2] = __builtin_bit_cast(float, v.y << 16); q[8 * i + 3] = __builtin_bit_cast(float, v.y & 0xffff0000u);
        q[8 * i + 4] = __builtin_bit_cast(float, v.z << 16); q[8 * i + 5] = __builtin_bit_cast(float, v.z & 0xffff0000u); q[8 * i + 6] = __builtin_bit_cast(float, v.w << 16); q[8 * i + 7] = __builtin_bit_cast(float, v.w & 0xffff0000u); }
    float sc[2];
#pragma unroll
    for (int h = 0; h < 2; ++h) { const int ks = s - 127 + h * 64 + lane; float a = -INFINITY;
        if (ks >= 0) { const bf16_t* kr = Kb + (size_t)(row - s + ks) * 256 + kvh * 64; a = 0.f;
#pragma unroll
            for (int i = 0; i < 8; ++i) { const u32x4 v = *(const u32x4*)(kr + i * 8);
                a += q[8 * i] * __builtin_bit_cast(float, v.x << 16) + q[8 * i + 1] * __builtin_bit_cast(float, v.x & 0xffff0000u) + q[8 * i + 2] * __builtin_bit_cast(float, v.y << 16) + q[8 * i + 3] * __builtin_bit_cast(float, v.y & 0xffff0000u)
                   + q[8 * i + 4] * __builtin_bit_cast(float, v.z << 16) + q[8 * i + 5] * __builtin_bit_cast(float, v.z & 0xffff0000u) + q[8 * i + 6] * __builtin_bit_cast(float, v.w << 16) + q[8 * i + 7] * __builtin_bit_cast(float, v.w & 0xffff0000u); } }
        sc[h] = a; }
    const float sink = p.in[9][hq] * LOG2E;
    const float m = fmaxf(wave_max(fmaxf(sc[0], sc[1])), sink);
    const float p0 = exp2f(sc[0] - m), p1 = exp2f(sc[1] - m);
    const float den = wave_sum(p0 + p1) + exp2f(sink - m);
    float o = 0.f;
    for (int j = 0; j < 64; ++j) {
        const float a0 = __shfl(p0, j), a1 = __shfl(p1, j);
        const int k0 = s - 127 + j, k1 = s - 63 + j;
        if (k0 >= 0) o += a0 * bf2f(Vb[(size_t)(row - s + k0) * 256 + kvh * 64 + lane]);
        if (k1 >= 0) o += a1 * bf2f(Vb[(size_t)(row - s + k1) * 256 + kvh * 64 + lane]);
    }
    ((bf16_t*)(p.ws + WS_RA + RA_O))[(size_t)row * 1024 + hq * 64 + lane] = (bf16_t)f2bf(o / den);
}
__global__ void __launch_bounds__(256) k_vstat_naive(Params p) {
    const int row = blockIdx.x * 4 + (threadIdx.x >> 6), lane = threadIdx.x & 63;
    const bf16_t* v = (const bf16_t*)(p.ws + WS_RA + RA_V2) + (size_t)row * GW;
    float s = 0.f, s2 = 0.f;
    for (int i = lane; i < GW; i += 64) { const float a = bf2f(v[i]); s += a; s2 += a * a; }
    s = wave_sum(s); s2 = wave_sum(s2);
    const float mean = s * (1.f / GW), var = fmaxf(s2 * (1.f / GW) - mean * mean, 0.f);
    if (lane == 0) { float* rs = (float*)(p.ws + WS_ROWSTAT) + (size_t)row * 2; rs[0] = mean; rs[1] = 1.f / sqrtf(var + LN_EPS); }
    if (lane < 32) { f32x2v o; o.x = lane == 0 ? s : 0.f; o.y = lane == 0 ? s2 : 0.f; *(f32x2v*)((float*)(p.ws + WS_VSTAT) + ((size_t)row * 32 + lane) * 2) = o; }
}
__global__ void __launch_bounds__(256) k_vstat_bridge(Params p) {
    const int row = blockIdx.x * 256 + threadIdx.x; const float* ps = (const float*)(p.ws + WS_VSTAT) + (size_t)row * 64;
    float s = 0.f, s2 = 0.f;
    for (int i = 0; i < 32; ++i) { s += ps[2 * i]; s2 += ps[2 * i + 1]; }
    const float mean = s * (1.f / GW), var = fmaxf(s2 * (1.f / GW) - mean * mean, 0.f);
    float* rs = (float*)(p.ws + WS_ROWSTAT) + (size_t)row * 2; rs[0] = mean; rs[1] = 1.f / sqrtf(var + LN_EPS);
}
__global__ void __launch_bounds__(256) k_gate_naive(Params p) {
    const size_t i = (size_t)blockIdx.x * 256 + threadIdx.x;
    const int t = (int)(i >> 11), c = (int)(i & 2047), tt = t & 127, t0 = t - tt, g = c >> 8;
    const bf16_t* v = (const bf16_t*)(p.ws + WS_RA + RA_V2); const bf16_t* u = (const bf16_t*)(p.ws + WS_RA + RA_U);
    const bf16_t* w = (const bf16_t*)(p.ws + WS_WS) + (size_t)(g * 128 + tt) * 128; const float* rs = (const float*)(p.ws + WS_ROWSTAT);
    const float lg = p.in[14][c], lb = p.in[15][c];
    float a = 0.f;
    for (int s = 0; s <= tt; ++s) { const float vn = (bf2f(v[(size_t)(t0 + s) * GW + c]) - rs[(size_t)(t0 + s) * 2]) * rs[(size_t)(t0 + s) * 2 + 1] * lg + lb; a += bf2f(w[s]) * vn; }
    a += p.in[17][g * 128 + tt];
    ((bf16_t*)(p.ws + WS_RA + RA_GATED))[i] = (bf16_t)f2bf(bf2f(u[i]) * a);
}
__global__ void __launch_bounds__(256) k_moe_prep(KA ka) {
    const Params& p = ka.p; const int l = ka.i0;
    __shared__ int tb[33];
    const int* cnt = (const int*)(p.ws + WS_CTL) + l * 32; const int* list = (const int*)(p.ws + WS_LIST) + (size_t)l * 32 * T; const float* wl = (const float*)(p.ws + WS_WL) + (size_t)l * 32 * T;
    int* rowmap = (int*)(p.ws + WS_TAB); float* wrow = (float*)(p.ws + WS_TAB) + MPAD; int* te = (int*)(p.ws + WS_TAB) + 2 * MPAD; int* nt = (int*)(p.ws + WS_CTL) + 64 + l;
    if (threadIdx.x == 0) { int a = 0; for (int e = 0; e < 32; ++e) { tb[e] = a; a += (cnt[e] + 255) >> 8; } tb[32] = a; *nt = a; }
    __syncthreads();
    for (int e = 0; e < 32; ++e) {
        const int n = cnt[e];
        for (int tl = tb[e]; tl < tb[e + 1]; ++tl) { if (threadIdx.x == 0) te[tl] = e;
            const int idx = (tl - tb[e]) * 256 + threadIdx.x; rowmap[tl * 256 + threadIdx.x] = idx < n ? list[(size_t)e * T + idx] : -1; wrow[tl * 256 + threadIdx.x] = idx < n ? wl[(size_t)e * T + idx] : 0.f; }
    }
}
__global__ void __launch_bounds__(256) k_moe1_post(KA ka) {
    const Params& p = ka.p; const int l = ka.i0;
    const size_t i = (size_t)blockIdx.x * 256 + threadIdx.x; const int m = (int)(i >> 8), c = (int)(i & 255);
    const int nt = ((const int*)(p.ws + WS_CTL))[64 + l]; if (m >= nt * 256) return;
    const float* gu = (const float*)(p.ws + WS_RA + RA_GURAW) + (size_t)m * 512; const float w = ((const float*)(p.ws + WS_TAB))[MPAD + m];
    const int pn = c >> 7, j = c & 127; const float g = gu[pn * 256 + j], u = gu[pn * 256 + 128 + j];
    ((bf16_t*)(p.ws + WS_RA + RA_ACT))[i] = (bf16_t)f2bf(silu_f(g) * u * w);
}


namespace pg8 {
#define PG8_LAS __attribute__((address_space(3)))
typedef short bf16x8 __attribute__((ext_vector_type(8)));
typedef float f32x2 __attribute__((ext_vector_type(2)));
constexpr int BM = 256, BK = 64, HALF = 128, HTB = HALF * BK * 2  , STAGE_BYTES = 8 * HTB, NXCD = 8, WGM = 8;

__host__ __device__ __forceinline__ int lds_byte(int r, int c) { const int st = (r >> 4) * 2 + (c >> 5), rr = r & 15, cc = c & 31, ob = rr * 64 + cc * 2; return st * 1024 + (ob ^ (((ob >> 9) & 1) << 5)); }
__host__ __device__ __forceinline__ void stage_rc(int b, int& R, int& C) { const int st = b / 1024, sb = b % 1024, swz = sb ^ (((sb >> 9) & 1) << 5); R = (st >> 1) * 16 + swz / 64; C = (st & 1) * 32 + (swz % 64) / 2; }
__host__ __device__ __forceinline__ int perm32(int rho) { const int n = rho >> 4, i = rho & 15; return 8 * (i >> 2) + 4 * n + (i & 3); }

struct Unit { int pm, pn; };
struct Gemm { const bf16_t* A; const bf16_t* Bt; int lda, ldb, K; };

struct StaticOrder {
    static constexpr bool GATHER = false;
    int nM, nN, nwg, G, c;
    __device__ void init(int M, int N, int G_, int c_) { nM = M / BM; nN = N / BM; nwg = nM * nN; G = G_; c = c_; }
    __device__ bool next(int i, Unit& u) const {
        const long L = (long)i * G + c; if (L >= nwg) return false;
        int wgid = (int)L; { const int q = nwg / NXCD, r = nwg % NXCD, xcd = wgid % NXCD, off = wgid / NXCD; wgid = (xcd < r ? xcd * (q + 1) : r * (q + 1) + (xcd - r) * q) + off; }
        const int nig = WGM * nN, gid = wgid / nig, fm = gid * WGM, gsz = (nM - fm) < WGM ? (nM - fm) : WGM;
        u.pm = fm + ((wgid % nig) % gsz); u.pn = (wgid % nig) / gsz; return true;
    }
    __device__ __forceinline__ const char* abase(const Gemm& g, const Unit& u) const { return (const char*)g.A + (size_t)u.pm * BM * g.lda * 2; }
    __device__ __forceinline__ const char* bbase(const Gemm& g, const Unit& u) const { return (const char*)g.Bt + (size_t)u.pn * BM * g.ldb * 2; }
    __device__ __forceinline__ unsigned arow(const Unit&, int) const { return 0u; }
};
template <bool GATHER_, int NPN_LOG2> struct MoeOrder {
    static constexpr bool GATHER = GATHER_;
    const PG8_LAS int* tab; const int* list; size_t bstride; int G, c;
    __device__ bool next(int i, Unit& u) const { const int L = i * G + c; if (L >= (tab[0] << NPN_LOG2)) return false; u.pm = L >> NPN_LOG2; u.pn = L & ((1 << NPN_LOG2) - 1); return true; }
    __device__ __forceinline__ const char* abase(const Gemm& g, const Unit& u) const { return GATHER_ ? (const char*)g.A : (const char*)g.A + (size_t)u.pm * BM * g.lda * 2; }
    __device__ __forceinline__ const char* bbase(const Gemm& g, const Unit& u) const { return (const char*)g.Bt + (size_t)tab[64 + u.pm] * bstride + (size_t)u.pn * BM * g.ldb * 2; }
    __device__ __forceinline__ unsigned arow(const Unit& u, int r) const { const int e = tab[64 + u.pm], idx = tab[224 + u.pm] + r; return idx < tab[1 + e] ? (unsigned)(list[(size_t)e * T + idx] >> 1) : 0u; }
};

typedef __bf16 bf16x2_t __attribute__((ext_vector_type(2)));
__device__ __forceinline__ unsigned cvt_pk_bf16(float lo, float hi) { const f32x2 v = {lo, hi}; const bf16x2_t b = __builtin_convertvector(v, bf16x2_t); return __builtin_bit_cast(unsigned, b); }
__device__ __forceinline__ f32x2 gelu_pk(f32x2 v) {
    const f32x2 av = __builtin_elementwise_abs(v), d = av * 0.2316418882f + 1.0f;
    f32x2 t; t.x = __builtin_amdgcn_rcpf(d.x); t.y = __builtin_amdgcn_rcpf(d.y);
    f32x2 q = t * 0.5307027145f + (-0.7265760135f); q = q * t + 0.7107068705f; q = q * t + (-0.142248368f); q = q * t + 0.127414796f; q = q * t;
    const f32x2 s = (v * v) * (-0.72134752044f);
    f32x2 e; e.x = __builtin_amdgcn_exp2f(s.x); e.y = __builtin_amdgcn_exp2f(s.y);
    const f32x2 m = v * (q * e), r = v - m;
    f32x2 o; o.x = v.x < 0.f ? m.x : r.x; o.y = v.y < 0.f ? m.y : r.y; return o;
}

typedef f32x4 Acc[2][2][4][2];

struct EpiQKV {
    static constexpr bool PERM = true;
    const float* bias; const float* rc; const float* rs; bf16_t* Q; bf16_t* Kb; bf16_t* Vb;
    __device__ __forceinline__ void operator()(const Acc& acc, const Unit& u, int wr, int wc, int fr, int fq) const {
        const int tile = u.pn; int scol; bf16_t* dst; int ld; float sc = 1.f;
        if (tile < 4) { scol = (tile * 4 + wc) * 64; dst = Q + scol; ld = 1024; sc = QSCALE; }
        else if (tile == 4) { scol = 1024 + wc * 64; dst = Kb + wc * 64; ld = 256; }
        else { scol = 1280 + wc * 64; dst = Vb + wc * 64; ld = 256; }
        f32x4 b1[2], b2[2];
#pragma unroll
        for (int n = 0; n < 2; ++n) { b1[n] = *(const f32x4*)(bias + scol + 8 * fq + 4 * n); b2[n] = *(const f32x4*)(bias + scol + 32 + 8 * fq + 4 * n); }
#pragma unroll
        for (int ai = 0; ai < 2; ++ai)
#pragma unroll
            for (int m = 0; m < 4; ++m) {
                const int row = u.pm * BM + ai * HALF + wr * 64 + m * 16 + fr;
                f32x4 o1[2], o2[2];
#pragma unroll
                for (int n = 0; n < 2; ++n) {
                    const f32x4 x1 = acc[ai][0][m][n] + b1[n], x2 = acc[ai][1][m][n] + b2[n];
                    if (tile < 5) { const f32x4 cs = *(const f32x4*)(rc + (size_t)row * 32 + 8 * fq + 4 * n), sn = *(const f32x4*)(rs + (size_t)row * 32 + 8 * fq + 4 * n);
                        o1[n] = (x1 * cs - x2 * sn) * sc; o2[n] = (x2 * cs + x1 * sn) * sc; }
                    else { o1[n] = x1; o2[n] = x2; }
                }
                u32x4 w1, w2;
                w1.x = cvt_pk_bf16(o1[0][0], o1[0][1]); w1.y = cvt_pk_bf16(o1[0][2], o1[0][3]); w1.z = cvt_pk_bf16(o1[1][0], o1[1][1]); w1.w = cvt_pk_bf16(o1[1][2], o1[1][3]);
                w2.x = cvt_pk_bf16(o2[0][0], o2[0][1]); w2.y = cvt_pk_bf16(o2[0][2], o2[0][3]); w2.z = cvt_pk_bf16(o2[1][0], o2[1][1]); w2.w = cvt_pk_bf16(o2[1][2], o2[1][3]);
                bf16_t* rp = dst + (size_t)row * ld + 8 * fq;
                *(u32x4*)rp = w1; *(u32x4*)(rp + 32) = w2;
            }
    }
};
struct EpiResid {
    static constexpr bool PERM = false;
    const float* x; const float* bias; const float* gt; float* z;
    __device__ __forceinline__ void operator()(const Acc& acc, const Unit& u, int wr, int wc, int fr, int fq) const {
        const int col0 = u.pn * BM + wc * 32 + 4 * fq; const int b = (u.pm * BM) >> 13;
        f32x4 bv[2][2], gv[2][2];
#pragma unroll
        for (int bj = 0; bj < 2; ++bj)
#pragma unroll
            for (int n = 0; n < 2; ++n) { bv[bj][n] = *(const f32x4*)(bias + col0 + bj * HALF + n * 16); gv[bj][n] = *(const f32x4*)(gt + b * 6144 + col0 + bj * HALF + n * 16) + 1.0f; }
#pragma unroll
        for (int ai = 0; ai < 2; ++ai)
#pragma unroll
            for (int m = 0; m < 4; ++m) { const size_t off = (size_t)(u.pm * BM + ai * HALF + wr * 64 + m * 16 + fr) * D + col0;
#pragma unroll
                for (int bj = 0; bj < 2; ++bj)
#pragma unroll
                    for (int n = 0; n < 2; ++n) { const f32x4 xv = *(const f32x4*)(x + off + bj * HALF + n * 16);
                        *(f32x4*)(z + off + bj * HALF + n * 16) = xv * ALPHA + gv[bj][n] * (acc[ai][bj][m][n] + bv[bj][n]); }
                if (m & 1) asm volatile("" ::: "memory"); }
    }
};
struct EpiGeluUV {
    static constexpr bool PERM = true;
    const float* bias; bf16_t* U; bf16_t* V2; float* vstat;
    __device__ __forceinline__ void operator()(const Acc& acc, const Unit& u, int wr, int wc, int fr, int fq) const {
        const bool isv = u.pn >= 8; bf16_t* base = isv ? V2 : U; const int colt = (isv ? u.pn - 8 : u.pn) * BM;
        const int col0 = colt + wc * 32 + 8 * fq, bcol0 = u.pn * BM + wc * 32 + 8 * fq;
        f32x4 bv[2][2];
#pragma unroll
        for (int bj = 0; bj < 2; ++bj)
#pragma unroll
            for (int n = 0; n < 2; ++n) bv[bj][n] = *(const f32x4*)(bias + bcol0 + bj * HALF + 4 * n);
#pragma unroll
        for (int ai = 0; ai < 2; ++ai)
#pragma unroll
            for (int m = 0; m < 4; ++m) { const int row = u.pm * BM + ai * HALF + wr * 64 + m * 16 + fr; bf16_t* rowp = base + (size_t)row * GW + col0; float s = 0.f, s2 = 0.f;
#pragma unroll
                for (int bj = 0; bj < 2; ++bj) { f32x4 v0 = acc[ai][bj][m][0] + bv[bj][0], v1 = acc[ai][bj][m][1] + bv[bj][1];
                    const f32x2 a = gelu_pk((f32x2){v0[0], v0[1]}), bb = gelu_pk((f32x2){v0[2], v0[3]}), c = gelu_pk((f32x2){v1[0], v1[1]}), d = gelu_pk((f32x2){v1[2], v1[3]});
                    s += (a.x + a.y) + (bb.x + bb.y) + (c.x + c.y) + (d.x + d.y);
                    s2 += (a.x * a.x + a.y * a.y) + (bb.x * bb.x + bb.y * bb.y) + (c.x * c.x + c.y * c.y) + (d.x * d.x + d.y * d.y);
                    u32x4 w; w.x = cvt_pk_bf16(a.x, a.y); w.y = cvt_pk_bf16(bb.x, bb.y); w.z = cvt_pk_bf16(c.x, c.y); w.w = cvt_pk_bf16(d.x, d.y);
                    *(u32x4*)(rowp + bj * HALF) = w; }
                if (isv) { s += __shfl_xor(s, 16); s += __shfl_xor(s, 32); s2 += __shfl_xor(s2, 16); s2 += __shfl_xor(s2, 32);
                    if (fq == 0) *(f32x2*)(vstat + ((size_t)row * 32 + (u.pn - 8) * 4 + wc) * 2) = (f32x2){s, s2}; } }
    }
};
struct EpiMoe1 {
    static constexpr bool PERM = true;
    const PG8_LAS int* tab; const float* wl; bf16_t* act;
    __device__ __forceinline__ void operator()(const Acc& acc, const Unit& u, int wr, int wc, int fr, int fq) const {
        const int e = tab[64 + u.pm], r0 = tab[224 + u.pm], n_e = tab[1 + e];
        const int col0 = u.pn * HALF + wc * 32 + 8 * fq;
#pragma unroll
        for (int ai = 0; ai < 2; ++ai)
#pragma unroll
            for (int m = 0; m < 4; ++m) { const int rl = ai * HALF + wr * 64 + m * 16 + fr; const int idx = r0 + rl;
                const float w = idx < n_e ? wl[(size_t)e * T + idx] : 0.f;
                f32x4 o[2];
#pragma unroll
                for (int n = 0; n < 2; ++n) { const f32x4 g = acc[ai][0][m][n], up = acc[ai][1][m][n];
#pragma unroll
                    for (int i = 0; i < 4; ++i) { const float sg = g[i] * __builtin_amdgcn_rcpf(1.f + __builtin_amdgcn_exp2f(-g[i] * LOG2E)); o[n][i] = idx < n_e ? sg * up[i] * w : 0.f; } }
                u32x4 wv; wv.x = cvt_pk_bf16(o[0][0], o[0][1]); wv.y = cvt_pk_bf16(o[0][2], o[0][3]); wv.z = cvt_pk_bf16(o[1][0], o[1][1]); wv.w = cvt_pk_bf16(o[1][2], o[1][3]);
                *(u32x4*)(act + (size_t)(u.pm * BM + rl) * EFF + col0) = wv; }
    }
};
struct EpiMoe2 {
    static constexpr bool PERM = true;
    const PG8_LAS int* tab; const int* list; bf16_t* y2;
    __device__ __forceinline__ void operator()(const Acc& acc, const Unit& u, int wr, int wc, int fr, int fq) const {
        const int e = tab[64 + u.pm], r0 = tab[224 + u.pm], n_e = tab[1 + e];
        const int col0 = u.pn * BM + wc * 32 + 8 * fq; const int* lp = list + (size_t)e * T + r0 + wr * 64 + fr;
#pragma unroll
        for (int ai = 0; ai < 2; ++ai) {
            int ts[4];
#pragma unroll
            for (int m = 0; m < 4; ++m) { const int idx = r0 + ai * HALF + wr * 64 + m * 16 + fr; ts[m] = idx < n_e ? lp[ai * HALF + m * 16] : -1; }
#pragma unroll
            for (int m = 0; m < 4; ++m) {
                if (ts[m] >= 0) { bf16_t* rowp = y2 + (size_t)ts[m] * D + col0;
#pragma unroll
                    for (int bj = 0; bj < 2; ++bj) { const f32x4 v0 = acc[ai][bj][m][0], v1 = acc[ai][bj][m][1];
                        u32x4 w; w.x = cvt_pk_bf16(v0[0], v0[1]); w.y = cvt_pk_bf16(v0[2], v0[3]); w.z = cvt_pk_bf16(v1[0], v1[1]); w.w = cvt_pk_bf16(v1[2], v1[3]);
                        *(u32x4*)(rowp + bj * HALF) = w; } }
                asm volatile("" ::: "memory"); }
        }
    }
};

template <class Epi, class Sched, bool ALIGN_EPI>
__device__ __forceinline__ void gemm_phase(PG8_LAS unsigned char* lds, const Gemm g, const Sched& S, const Epi& E) {
    const int tid = fresh_tid();
    const int wid = __builtin_amdgcn_readfirstlane(tid >> 6), lane = tid & 63, wr = wid >> 2, wc = wid & 3, fr = lane & 15, fq = lane >> 4;
    const int K = g.K, nt = K / BK;
    int RA[2], CA[2]; unsigned voffB[2][2], cvA[2][2], nvA[2][2];
#pragma unroll
    for (int i = 0; i < 2; ++i) { int R, C; stage_rc(tid * 16 + i * 8192, R, C); const int Rb = Epi::PERM ? ((R & ~31) + perm32(R & 31)) : R; RA[i] = R; CA[i] = C;
#pragma unroll
        for (int h = 0; h < 2; ++h) { voffB[h][i] = (unsigned)((Rb + h * HALF) * g.ldb + C) * 2u; cvA[h][i] = (unsigned)((R + h * HALF) * g.lda + C) * 2u; nvA[h][i] = cvA[h][i]; } }
    const size_t kstep = (size_t)(BK * 2);
    const unsigned ldsw = (unsigned)wid * 1024u;
    const int aoff = lds_byte(wr * 64 + fr, fq * 8), boff = lds_byte(wc * 32 + fr, fq * 8);
#define PG8_SA(b, h) (((b) * 2 + (h)) * HTB)
#define PG8_SB(b, h) ((4 + (b) * 2 + (h)) * HTB)
#define PG8_STAGE(bufoff, gbase, voff) do { _Pragma("unroll") for (int _i = 0; _i < 2; ++_i) \
        __builtin_amdgcn_global_load_lds((const unsigned*)((const char*)(gbase) + (voff)[_i]), (PG8_LAS unsigned*)(lds + (bufoff) + ldsw + _i * 8192), 16, 0, 0); } while (0)
#define PG8_LDA(dst, b, h) do { _Pragma("unroll") for (int m = 0; m < 4; ++m) _Pragma("unroll") for (int k = 0; k < 2; ++k) dst[m][k] = *(const PG8_LAS bf16x8*)(lds + PG8_SA(b, h) + aoff + m * 2048 + k * 1024); } while (0)
#define PG8_LDB(dst, b, h) do { _Pragma("unroll") for (int n = 0; n < 2; ++n) _Pragma("unroll") for (int k = 0; k < 2; ++k) dst[n][k] = *(const PG8_LAS bf16x8*)(lds + PG8_SB(b, h) + boff + n * 2048 + k * 1024); } while (0)
#define PG8_MMA(ai, bj, At, Bt) do { __builtin_amdgcn_s_setprio(1); _Pragma("unroll") for (int m = 0; m < 4; ++m) _Pragma("unroll") for (int n = 0; n < 2; ++n) _Pragma("unroll") for (int k = 0; k < 2; ++k) \
        acc[ai][bj][m][n] = __builtin_amdgcn_mfma_f32_16x16x32_bf16(Bt[n][k], At[m][k], acc[ai][bj][m][n], 0, 0, 0); __builtin_amdgcn_s_setprio(0); } while (0)
#define PG8_WAIT_V(n) asm volatile("s_waitcnt vmcnt(" #n ")" ::: "memory")
#define PG8_WAIT_L(n) asm volatile("s_waitcnt lgkmcnt(" #n ")" ::: "memory")
#define PG8_BAR __builtin_amdgcn_s_barrier()
#define PG8_SCHED __builtin_amdgcn_sched_barrier(0)
#define PG8_GATHER(dst, un) do { _Pragma("unroll") for (int _i = 0; _i < 2; ++_i) _Pragma("unroll") for (int _h = 0; _h < 2; ++_h) dst[_h][_i] = (S.arow(un, _h * HALF + RA[_i]) * (unsigned)g.lda + (unsigned)CA[_i]) * 2u; } while (0)
    Unit cur, nxt; int ui = 0;
    if (!S.next(0, cur)) return;
    Acc acc;
#pragma unroll
    for (int a = 0; a < 2; ++a)
#pragma unroll
        for (int b = 0; b < 2; ++b)
#pragma unroll
            for (int m = 0; m < 4; ++m)
#pragma unroll
                for (int n = 0; n < 2; ++n) acc[a][b][m][n] = (f32x4){0.f, 0.f, 0.f, 0.f};
    bf16x8 At[4][2], B0[2][2], B1[2][2];
    if constexpr (Sched::GATHER) { PG8_GATHER(cvA, cur); }
    const char* cA = S.abase(g, cur); const char* cB = S.bbase(g, cur);
    PG8_STAGE(PG8_SB(0, 0), cB, voffB[0]); PG8_STAGE(PG8_SB(0, 1), cB, voffB[1]); PG8_STAGE(PG8_SA(0, 0), cA, cvA[0]); PG8_STAGE(PG8_SA(0, 1), cA, cvA[1]);
    if (wr == 1) PG8_BAR;
    PG8_WAIT_V(2); PG8_BAR;
    PG8_STAGE(PG8_SB(1, 0), cB + kstep, voffB[0]); PG8_STAGE(PG8_SA(1, 0), cA + kstep, cvA[0]); PG8_STAGE(PG8_SB(1, 1), cB + kstep, voffB[1]);
    PG8_WAIT_V(6); PG8_BAR;
    for (;;) {
        const bool has_next = S.next(ui + 1, nxt);
        if constexpr (Sched::GATHER) { if (has_next) { PG8_GATHER(nvA, nxt); } else {
#pragma unroll
            for (int i = 0; i < 2; ++i) { nvA[0][i] = cvA[0][i]; nvA[1][i] = cvA[1][i]; } } }
        const char* nA = has_next ? S.abase(g, nxt) : cA; const char* nB = has_next ? S.bbase(g, nxt) : cB;
#pragma unroll 1
        for (int t = 0; t < nt; t += 2) {
            const bool last = (t == nt - 2);
            const char* a1 = cA + (size_t)(t + 1) * kstep;
            const char* a2 = last ? nA : cA + (size_t)(t + 2) * kstep; const char* b2 = last ? nB : cB + (size_t)(t + 2) * kstep;
            const char* a3 = a2 + kstep; const char* b3 = b2 + kstep;
            unsigned wA[2][2];
#pragma unroll
            for (int i = 0; i < 2; ++i) { wA[0][i] = (Sched::GATHER && last) ? nvA[0][i] : cvA[0][i]; wA[1][i] = (Sched::GATHER && last) ? nvA[1][i] : cvA[1][i]; }
            PG8_LDB(B0, 0, 0); PG8_LDB(B1, 0, 1); PG8_SCHED; PG8_LDA(At, 0, 0); PG8_STAGE(PG8_SA(1, 1), a1, cvA[1]);
            PG8_WAIT_V(8); PG8_WAIT_L(0); PG8_BAR; PG8_MMA(0, 0, At, B0); PG8_MMA(0, 1, At, B1); PG8_BAR; PG8_SCHED;
            PG8_LDA(At, 0, 1); PG8_STAGE(PG8_SB(0, 0), b2, voffB[0]); PG8_STAGE(PG8_SB(0, 1), b2, voffB[1]); PG8_STAGE(PG8_SA(0, 0), a2, wA[0]);
            PG8_WAIT_V(8); PG8_WAIT_L(0); PG8_BAR; PG8_MMA(1, 0, At, B0); PG8_MMA(1, 1, At, B1); PG8_BAR; PG8_SCHED;
            PG8_LDB(B0, 1, 0); PG8_LDB(B1, 1, 1); PG8_SCHED; PG8_LDA(At, 1, 0); PG8_STAGE(PG8_SA(0, 1), a2, wA[1]);
            PG8_WAIT_V(8); PG8_WAIT_L(0); PG8_BAR; PG8_MMA(0, 0, At, B0); PG8_MMA(0, 1, At, B1); PG8_BAR; PG8_SCHED;
            PG8_LDA(At, 1, 1); PG8_STAGE(PG8_SB(1, 0), b3, voffB[0]); PG8_STAGE(PG8_SB(1, 1), b3, voffB[1]); PG8_STAGE(PG8_SA(1, 0), a3, wA[0]);
            PG8_WAIT_V(8); PG8_WAIT_L(0); PG8_BAR; PG8_MMA(1, 0, At, B0); PG8_MMA(1, 1, At, B1); PG8_BAR; PG8_SCHED;
        }
        if constexpr (ALIGN_EPI) { if (wr == 0) PG8_BAR; }
        E(acc, cur, wr, wc, fr, fq);
        if (!has_next) break;
#pragma unroll
        for (int a = 0; a < 2; ++a)
#pragma unroll
            for (int b = 0; b < 2; ++b)
#pragma unroll
                for (int m = 0; m < 4; ++m)
#pragma unroll
                    for (int n = 0; n < 2; ++n) acc[a][b][m][n] = (f32x4){0.f, 0.f, 0.f, 0.f};
        cur = nxt; cA = nA; cB = nB; ++ui;
#pragma unroll
        for (int i = 0; i < 2; ++i) { cvA[0][i] = nvA[0][i]; cvA[1][i] = nvA[1][i]; }
        if constexpr (ALIGN_EPI) { if (wr == 1) PG8_BAR; }
    }
    PG8_WAIT_V(0);
    if constexpr (!ALIGN_EPI) { if (wr == 0) PG8_BAR; }
    PG8_BAR;
#undef PG8_SA
#undef PG8_SB
#undef PG8_STAGE
#undef PG8_LDA
#undef PG8_LDB
#undef PG8_MMA
#undef PG8_WAIT_V
#undef PG8_WAIT_L
#undef PG8_BAR
#undef PG8_SCHED
#undef PG8_GATHER
}
}


namespace attn {
typedef float f32x16 __attribute__((ext_vector_type(16)));
typedef short bf16x8 __attribute__((ext_vector_type(8)));
typedef short s16x4 __attribute__((ext_vector_type(4)));
constexpr int KSTR = 144, VSTR = 192;
constexpr int LDS_K = 0, LDS_V = 256 * KSTR, LDS_END = LDS_V + 256 * VSTR;
__device__ __forceinline__ int crow(int i, int h) { return (i & 3) + 8 * (i >> 2) + 4 * h; }
__device__ __forceinline__ s16x4 vtr(const PG8_LAS unsigned char* p) { return __builtin_bit_cast(s16x4, __builtin_amdgcn_ds_read_tr16_b64_v4i16((__attribute__((address_space(3))) s16x4*)p)); }

__device__ __forceinline__ void attn_phase(const Params& p, PG8_LAS unsigned char* lds, int bid, int G) {
    const int tid = fresh_tid(), wid = __builtin_amdgcn_readfirstlane(tid >> 6), lane = tid & 63, r = lane & 31, h = lane >> 5;
    const bf16_t* Q = (const bf16_t*)(p.ws + WS_RA + RA_Q); const bf16_t* Kb = (const bf16_t*)(p.ws + WS_RA + RA_K); const bf16_t* Vb = (const bf16_t*)(p.ws + WS_RA + RA_V);
    bf16_t* O = (bf16_t*)(p.ws + WS_RA + RA_O);
#pragma unroll 1
    for (int unit = bid; unit < 512; unit += G) {
        const int kvh = unit & 3, qblk = (unit >> 2) & 63, b = unit >> 8;
        const size_t row0 = (size_t)b * SEQ + (size_t)qblk * 128;
        __syncthreads();
#pragma unroll
        for (int i = 0; i < 4; ++i) { const int pc = i * 512 + tid, key = pc >> 3, c = pc & 7;
            u32x4 kv = (u32x4){0u, 0u, 0u, 0u}, vv = (u32x4){0u, 0u, 0u, 0u};
            if (qblk > 0 || key >= 128) { const size_t gr = row0 + key - 128; kv = *(const u32x4*)(Kb + gr * 256 + kvh * 64 + c * 8); vv = *(const u32x4*)(Vb + gr * 256 + kvh * 64 + c * 8); }
            *(PG8_LAS u32x4*)(lds + LDS_K + key * KSTR + c * 16) = kv; *(PG8_LAS u32x4*)(lds + LDS_V + key * VSTR + c * 16) = vv; }
        __syncthreads();
        const int hq = kvh * 4 + (wid >> 1), qhalf = wid & 1;
        const float sink = p.in[9][hq] * LOG2E;
#pragma unroll 1
        for (int qt = 0; qt < 2; ++qt) {
            const int q0 = qhalf * 64 + qt * 32, kt0 = q0 >> 5;
            bf16x8 qf[4]; const bf16_t* qp = Q + (row0 + q0 + r) * 1024 + hq * 64 + h * 8;
#pragma unroll
            for (int d0 = 0; d0 < 4; ++d0) qf[d0] = *(const bf16x8*)(qp + d0 * 16);
            f32x16 s[5];
#pragma unroll
            for (int t = 0; t < 5; ++t) {
#pragma unroll
                for (int i = 0; i < 16; ++i) s[t][i] = 0.f;
                const PG8_LAS unsigned char* kp = lds + LDS_K + (32 * (kt0 + t) + r) * KSTR + h * 16;
#pragma unroll
                for (int d0 = 0; d0 < 4; ++d0) { const bf16x8 kf = *(const PG8_LAS bf16x8*)(kp + d0 * 32); s[t] = __builtin_amdgcn_mfma_f32_32x32x16_bf16(kf, qf[d0], s[t], 0, 0, 0); }
            }
#pragma unroll
            for (int i = 0; i < 16; ++i) { const int kk = crow(i, h); s[0][i] = kk > r ? s[0][i] : -INFINITY; s[4][i] = kk <= r ? s[4][i] : -INFINITY; }
            if (qblk == 0) {
#pragma unroll
                for (int t = 0; t < 4; ++t) if (kt0 + t < 4) {
#pragma unroll
                    for (int i = 0; i < 16; ++i) s[t][i] = -INFINITY; }
            }
            float m = sink;
#pragma unroll
            for (int t = 0; t < 5; ++t)
#pragma unroll
                for (int i = 0; i < 16; ++i) m = fmaxf(m, s[t][i]);
            m = fmaxf(m, __shfl_xor(m, 32));
            float sum = 0.f;
#pragma unroll
            for (int t = 0; t < 5; ++t)
#pragma unroll
                for (int i = 0; i < 16; ++i) { s[t][i] = __builtin_amdgcn_exp2f(s[t][i] - m); sum += s[t][i]; }
            sum += __shfl_xor(sum, 32); sum += __builtin_amdgcn_exp2f(sink - m);
            const float rinv = 1.f / sum;
            f32x16 o[2];
#pragma unroll
            for (int i = 0; i < 16; ++i) { o[0][i] = 0.f; o[1][i] = 0.f; }
#pragma unroll
            for (int t = 0; t < 5; ++t)
#pragma unroll
                for (int ss = 0; ss < 2; ++ss) {
                    u32x4 pw; pw.x = pg8::cvt_pk_bf16(s[t][8 * ss] * rinv, s[t][8 * ss + 1] * rinv); pw.y = pg8::cvt_pk_bf16(s[t][8 * ss + 2] * rinv, s[t][8 * ss + 3] * rinv);
                    pw.z = pg8::cvt_pk_bf16(s[t][8 * ss + 4] * rinv, s[t][8 * ss + 5] * rinv); pw.w = pg8::cvt_pk_bf16(s[t][8 * ss + 6] * rinv, s[t][8 * ss + 7] * rinv);
                    const bf16x8 pa = __builtin_bit_cast(bf16x8, pw);
                    const PG8_LAS unsigned char* vp = lds + LDS_V + (32 * (kt0 + t) + 16 * ss + 4 * h + ((lane & 15) >> 2)) * VSTR + (16 * ((lane >> 4) & 1) + 4 * (lane & 3)) * 2;
#pragma unroll
                    for (int d0 = 0; d0 < 2; ++d0) { const s16x4 lo = vtr(vp + d0 * 64), hi = vtr(vp + d0 * 64 + 8 * VSTR);
                        const bf16x8 vb = (bf16x8){lo[0], lo[1], lo[2], lo[3], hi[0], hi[1], hi[2], hi[3]};
                        o[d0] = __builtin_amdgcn_mfma_f32_32x32x16_bf16(pa, vb, o[d0], 0, 0, 0); }
                }
            bf16_t* op = O + (row0 + q0) * 1024 + hq * 64 + r;
#pragma unroll
            for (int i = 0; i < 16; ++i) { const int q = crow(i, h); op[(size_t)q * 1024] = (bf16_t)(pg8::cvt_pk_bf16(o[0][i], 0.f) & 0xffffu); op[(size_t)q * 1024 + 32] = (bf16_t)(pg8::cvt_pk_bf16(o[1][i], 0.f) & 0xffffu); }
        }
    }
    __syncthreads();
}
}

namespace sgu {
typedef float f32x16 __attribute__((ext_vector_type(16)));
typedef short bf16x8 __attribute__((ext_vector_type(8)));
typedef short s16x4 __attribute__((ext_vector_type(4)));
constexpr int WSTR = 272, VSTR = 576;
constexpr int LDS_W = 0, LDS_VN = 128 * WSTR, LDS_ST = LDS_VN + 128 * VSTR, LDS_BS = LDS_ST + 128 * 8, LDS_END = LDS_BS + 512;
__device__ __forceinline__ void gate_phase(const Params& p, PG8_LAS unsigned char* lds, int bid, int G) {
    const int tid = fresh_tid(), wid = __builtin_amdgcn_readfirstlane(tid >> 6), lane = tid & 63, r = lane & 31, h = lane >> 5;
    const bf16_t* U = (const bf16_t*)(p.ws + WS_RA + RA_U); const bf16_t* V2 = (const bf16_t*)(p.ws + WS_RA + RA_V2); bf16_t* GT = (bf16_t*)(p.ws + WS_RA + RA_GATED);
    const bf16_t* Wsb = (const bf16_t*)(p.ws + WS_WS); const float* vstat = (const float*)(p.ws + WS_VSTAT);
    PG8_LAS float* st = (PG8_LAS float*)(lds + LDS_ST); PG8_LAS float* bs = (PG8_LAS float*)(lds + LDS_BS);
#pragma unroll 1
    for (int unit = bid; unit < 1024; unit += G) {
        const int g = unit & 7, chunk = unit >> 3; const size_t row0 = (size_t)chunk * 128;
        __syncthreads();
        { const int row = tid >> 2, qd = tid & 3; const float* ps = vstat + ((row0 + row) * 32 + qd * 8) * 2; float a = 0.f, a2 = 0.f;
#pragma unroll
            for (int i = 0; i < 4; ++i) { const f32x4 v = *(const f32x4*)(ps + 4 * i); a += v.x + v.z; a2 += v.y + v.w; }
            a += __shfl_xor(a, 1); a += __shfl_xor(a, 2); a2 += __shfl_xor(a2, 1); a2 += __shfl_xor(a2, 2);
            const float mean = a * (1.f / GW), var = fmaxf(a2 * (1.f / GW) - mean * mean, 0.f);
            if (qd == 0) { st[row * 2] = mean; st[row * 2 + 1] = 1.f / sqrtf(var + LN_EPS); }
            if (tid < 128) bs[tid] = p.in[17][g * 128 + tid]; }
#pragma unroll
        for (int i = 0; i < 4; ++i) { const int pc = i * 512 + tid, t = pc >> 4, c = pc & 15;
            *(PG8_LAS u32x4*)(lds + LDS_W + t * WSTR + c * 16) = *(const u32x4*)(Wsb + (size_t)(g * 128 + t) * 128 + c * 8); }
        __syncthreads();
        { const int c = tid & 31; const int col = g * 256 + c * 8;
            const f32x4 g0 = *(const f32x4*)(p.in[14] + col), g1 = *(const f32x4*)(p.in[14] + col + 4), b0 = *(const f32x4*)(p.in[15] + col), b1 = *(const f32x4*)(p.in[15] + col + 4);
#pragma unroll
            for (int i = 0; i < 8; ++i) { const int srow = i * 16 + (tid >> 5);
                const u32x4 v = *(const u32x4*)(V2 + (row0 + srow) * GW + col); const float mu = st[srow * 2], rs = st[srow * 2 + 1];
                f32x4 x0, x1; x0.x = __builtin_bit_cast(float, v.x << 16); x0.y = __builtin_bit_cast(float, v.x & 0xffff0000u); x0.z = __builtin_bit_cast(float, v.y << 16); x0.w = __builtin_bit_cast(float, v.y & 0xffff0000u);
                x1.x = __builtin_bit_cast(float, v.z << 16); x1.y = __builtin_bit_cast(float, v.z & 0xffff0000u); x1.z = __builtin_bit_cast(float, v.w << 16); x1.w = __builtin_bit_cast(float, v.w & 0xffff0000u);
                x0 = (x0 - mu) * rs * g0 + b0; x1 = (x1 - mu) * rs * g1 + b1;
                u32x4 w; w.x = pg8::cvt_pk_bf16(x0.x, x0.y); w.y = pg8::cvt_pk_bf16(x0.z, x0.w); w.z = pg8::cvt_pk_bf16(x1.x, x1.y); w.w = pg8::cvt_pk_bf16(x1.z, x1.w);
                *(PG8_LAS u32x4*)(lds + LDS_VN + srow * VSTR + c * 16) = w; } }
        __syncthreads();
        bf16x8 bf[8];
        { const PG8_LAS unsigned char* vp = lds + LDS_VN + (8 * h + ((lane & 15) >> 2)) * VSTR + (32 * wid + 16 * ((lane >> 4) & 1) + 4 * (lane & 3)) * 2;
#pragma unroll
            for (int ks = 0; ks < 8; ++ks) { const s16x4 lo = attn::vtr(vp + ks * 16 * VSTR), hi = attn::vtr(vp + ks * 16 * VSTR + 4 * VSTR);
                bf[ks] = (bf16x8){lo[0], lo[1], lo[2], lo[3], hi[0], hi[1], hi[2], hi[3]}; } }
#pragma unroll
        for (int tt = 0; tt < 4; ++tt) {
            f32x16 acc;
#pragma unroll
            for (int i = 0; i < 16; ++i) acc[i] = 0.f;
            const PG8_LAS unsigned char* wp = lds + LDS_W + (32 * tt + r) * WSTR + h * 16;
#pragma unroll
            for (int ks = 0; ks < 2 * tt + 2; ++ks) { const bf16x8 af = *(const PG8_LAS bf16x8*)(wp + ks * 32); acc = __builtin_amdgcn_mfma_f32_32x32x16_bf16(af, bf[ks], acc, 0, 0, 0); }
            const size_t obase = (row0 + 32 * tt) * GW + g * 256 + 32 * wid + r;
#pragma unroll
            for (int i = 0; i < 16; ++i) { const int t = attn::crow(i, h); const float mixed = acc[i] + bs[32 * tt + t];
                const float u = bf2f(U[obase + (size_t)t * GW]); GT[obase + (size_t)t * GW] = (bf16_t)(pg8::cvt_pk_bf16(u * mixed, 0.f) & 0xffffu); }
        }
    }
    __syncthreads();
}
}

namespace cg = cooperative_groups;
constexpr int LDS_BYTES = 152 * 1024, MISC_OFF = 147456;
struct MArgs { Params p; int lo, hi; };
constexpr int NPHASE = 16;

__device__ __forceinline__ void moe_build_tab(const Params& p, int l, PG8_LAS int* tab) {
    const int tid = fresh_tid();
    if (tid < 64) {
        const int n = tid < 32 ? ((const int*)(p.ws + WS_CTL))[l * 32 + tid] : 0; const int ntl = (n + 255) >> 8;
        int incl = ntl;
#pragma unroll
        for (int o = 1; o < 64; o <<= 1) { const int v = __shfl_up(incl, o); if (tid >= o) incl += v; }
        const int off = incl - ntl;
        if (tid < 32) { tab[1 + tid] = n; for (int j = 0; j < ntl; ++j) { tab[64 + off + j] = tid; tab[224 + off + j] = j * 256; } }
        if (tid == 31) tab[0] = incl;
    }
    __syncthreads();
}

__global__ void __launch_bounds__(512, 2) mega(MArgs a) {
    extern __shared__ __attribute__((aligned(16))) unsigned char lds_raw[];
    cg::grid_group grid = cg::this_grid();
    PG8_LAS unsigned char* lds = (PG8_LAS unsigned char*)lds_raw;
    PG8_LAS int* tab = (PG8_LAS int*)(lds + MISC_OFF);
    const Params& p = a.p; unsigned char* ws = p.ws;
    const int lo = a.lo, hi = a.hi, G = gridDim.x, bid = blockIdx.x;
    float* Z = p.out; float* X1 = (float*)(ws + WS_X1); float* X2 = (float*)(ws + WS_X2); const float* mod = (const float*)(ws + WS_MOD);
    bf16_t* H = (bf16_t*)(ws + WS_H);
#ifndef TESTPH
#define TESTPH -1
#endif
#define INC(c, k) ((TESTPH < 0 || TESTPH == (c)) && lo <= (k) && (k) < hi)
#define IN(k) INC(k, k)
#define SEAM(k) do { if (lo <= (k) && (k) + 1 < hi) { asm volatile("s_waitcnt vmcnt(0) lgkmcnt(0)" ::: "memory"); grid.sync(); \
        __builtin_amdgcn_fence(__ATOMIC_ACQUIRE, "agent"); asm volatile("s_waitcnt vmcnt(0)" ::: "memory"); } } while (0)
#define MOE_BLOCK(l, pb) { \
        const int* list = (const int*)(ws + WS_LIST) + (size_t)(l) * 32 * T; const float* wl = (const float*)(ws + WS_WL) + (size_t)(l) * 32 * T; \
        if (INC(5, (pb) + 5)) { phase_ln_router(p, (l), Z, X1, bid, G, (float*)lds_raw); __syncthreads(); } SEAM((pb) + 5); \
        if (INC(6, (pb) + 6)) { \
            moe_build_tab(p, (l), tab); \
            pg8::Gemm g{H, (const bf16_t*)(ws + WS_WGU) + (size_t)(l) * 32 * 512 * 1024, D, D, D}; \
            pg8::MoeOrder<true, 1> S{tab, list, (size_t)512 * 1024 * 2, G, bid}; \
            pg8::EpiMoe1 E{tab, wl, (bf16_t*)(ws + WS_RA + RA_ACT)}; \
            pg8::gemm_phase<pg8::EpiMoe1, pg8::MoeOrder<true, 1>, true>(lds, g, S, E); \
        } SEAM((pb) + 6); \
        if (INC(7, (pb) + 7)) { \
            moe_build_tab(p, (l), tab); \
            pg8::Gemm g{(const bf16_t*)(ws + WS_RA + RA_ACT), (const bf16_t*)(ws + WS_WD) + (size_t)(l) * 32 * 1024 * 256, EFF, EFF, EFF}; \
            pg8::MoeOrder<false, 2> S{tab, list, (size_t)1024 * 256 * 2, G, bid}; \
            pg8::EpiMoe2 E{tab, list, (bf16_t*)(ws + WS_RA + RA_Y2)}; \
            pg8::gemm_phase<pg8::EpiMoe2, pg8::MoeOrder<false, 2>, true>(lds, g, S, E); \
        } SEAM((pb) + 7); \
        if (INC(8, (pb) + 8)) { phase_ln2(p, (l), X1, (l) == 0 ? X2 : p.out, (l) == 0 ? 1 : -1, bid, G); } SEAM((pb) + 8); }
    if (IN(0)) { p0_prologue(p, bid, G, (float*)lds_raw); } SEAM(0);
    if (IN(1)) { phase_h0(p, bid, G); } SEAM(1);
    if (IN(2)) {
        pg8::Gemm g{H, (const bf16_t*)(ws + WS_WQKV), D, D, D}; pg8::StaticOrder S; S.init(T, NQKV, G, bid);
        pg8::EpiQKV E{p.in[8], (const float*)(ws + WS_ROPE_C), (const float*)(ws + WS_ROPE_S), (bf16_t*)(ws + WS_RA + RA_Q), (bf16_t*)(ws + WS_RA + RA_K), (bf16_t*)(ws + WS_RA + RA_V)};
        pg8::gemm_phase<pg8::EpiQKV, pg8::StaticOrder, true>(lds, g, S, E);
    } SEAM(2);
    if (IN(3)) { attn::attn_phase(p, lds, bid, G); } SEAM(3);
    if (IN(4)) {
        pg8::Gemm g{(const bf16_t*)(ws + WS_RA + RA_O), (const bf16_t*)(ws + WS_WO), D, D, D}; pg8::StaticOrder S; S.init(T, D, G, bid);
        pg8::EpiResid E{p.in[0], p.in[11], mod + 2 * 1024, Z};
        pg8::gemm_phase<pg8::EpiResid, pg8::StaticOrder, true>(lds, g, S, E);
    } SEAM(4);
    MOE_BLOCK(0, 0)
    if (IN(9)) {
        pg8::Gemm g{H, (const bf16_t*)(ws + WS_WIN), D, D, D}; pg8::StaticOrder S; S.init(T, 2 * GW, G, bid);
        pg8::EpiGeluUV E{p.in[13], (bf16_t*)(ws + WS_RA + RA_U), (bf16_t*)(ws + WS_RA + RA_V2), (float*)(ws + WS_VSTAT)};
        pg8::gemm_phase<pg8::EpiGeluUV, pg8::StaticOrder, true>(lds, g, S, E);
    } SEAM(9);
    if (IN(10)) { sgu::gate_phase(p, lds, bid, G); } SEAM(10);
    if (IN(11)) {
        pg8::Gemm g{(const bf16_t*)(ws + WS_RA + RA_GATED), (const bf16_t*)(ws + WS_WOUT), GW, GW, GW}; pg8::StaticOrder S; S.init(T, D, G, bid);
        pg8::EpiResid E{X2, p.in[19], mod + 2 * 6144 + 2 * 1024, Z};
        pg8::gemm_phase<pg8::EpiResid, pg8::StaticOrder, true>(lds, g, S, E);
    } SEAM(11);
    MOE_BLOCK(1, 7)
#undef IN
#undef SEAM
#undef MOE_BLOCK
}

static const bool FAST[NPHASE] = {1, 1, 1, 1, 1, 1, 1, 1, 1, 1, 1, 1, 1, 1, 1, 1};
static const bool CUT[NPHASE + 1] = {0, 0, 0, 0, 0, 0, 0, 0, 0, 0, 0, 0, 0, 0, 0, 0, 0};

extern "C" void kernel_launch(void* const* d_in, const int* in_sizes, int n_in, void* d_out, int out_size, void* d_ws, size_t ws_size, hipStream_t stream) {
    if (n_in != 26 || out_size != T * D || ws_size < WS_END) { fprintf(stderr, "kernel_launch: unexpected problem (n_in %d out %d ws %zu)\n", n_in, out_size, ws_size); return; }
    static int grid = 0;
    if (!grid) {
        (void)hipFuncSetAttribute((const void*)k_ln_router, hipFuncAttributeMaxDynamicSharedMemorySize, 36 * 1024 * 4);
        (void)hipFuncSetAttribute((const void*)mega, hipFuncAttributeMaxDynamicSharedMemorySize, LDS_BYTES);
        int dev = 0, cus = 0, per_cu = 0;
        (void)hipGetDevice(&dev); (void)hipDeviceGetAttribute(&cus, hipDeviceAttributeMultiprocessorCount, dev);
        (void)hipOccupancyMaxActiveBlocksPerMultiprocessor(&per_cu, (const void*)mega, 512, LDS_BYTES);
        if (per_cu < 1) { fprintf(stderr, "kernel_launch: occupancy query says %d blocks per CU\n", per_cu); per_cu = 1; }
        grid = cus;
        fprintf(stderr, "kernel_launch: cus %d per_cu %d grid %d\n", cus, per_cu, grid);
    }
    Params p{};
    for (int i = 0; i < 26; ++i) p.in[i] = (const float*)d_in[i];
    p.out = (float*)d_out; p.ws = (unsigned char*)d_ws;
    unsigned char* ws = p.ws;
    float* Z = p.out; float* X1 = (float*)(ws + WS_X1); float* X2 = (float*)(ws + WS_X2); const float* mod = (const float*)(ws + WS_MOD);
    bf16_t* H = (bf16_t*)(ws + WS_H);
    const int* rowmap = (const int*)(ws + WS_TAB); const int* te = (const int*)(ws + WS_TAB) + 2 * MPAD;
    int k = 0;
    while (k < NPHASE) {
        if (FAST[k]) {
            int e = k + 1; while (e < NPHASE && FAST[e] && !CUT[e]) ++e;
            MArgs ma{p, k, e}; void* args[] = {&ma};
            const hipError_t err = hipLaunchCooperativeKernel((const void*)mega, dim3(grid), dim3(512), args, LDS_BYTES, stream);
            if (err != hipSuccess) fprintf(stderr, "kernel_launch: cooperative launch [%d,%d) failed: %s\n", k, e, hipGetErrorString(err));
            k = e; continue;
        }
        const int l = k >= 9 ? 1 : 0; const int ph = (k >= 12) ? k - 7 : k;
        const int* nt = (const int*)(ws + WS_CTL) + 64 + l;
        switch (ph) {
        case 0: hipLaunchKernelGGL(k_prologue, dim3(256), dim3(512), 0, stream, p); break;
        case 1: hipLaunchKernelGGL(k_h0, dim3(256), dim3(512), 0, stream, p); break;
        case 2: { NG g{H, nullptr, (const bf16_t*)(ws + WS_WQKV), nullptr, nullptr, 0, D, D, D, 0};
            hipLaunchKernelGGL(ngemm<NEpiF32>, dim3(NQKV / 64, T / 64), dim3(256), 0, stream, g, NEpiF32{(float*)(ws + WS_RA + RA_QKVRAW), NQKV, 0});
            hipLaunchKernelGGL(k_rope_post, dim3(T * 768 / 256), dim3(256), 0, stream, p); } break;
        case 3: hipLaunchKernelGGL(k_attn_naive, dim3(T * 16 / 4), dim3(256), 0, stream, p); break;
        case 4: { NG g2{(const bf16_t*)(ws + WS_RA + RA_O), nullptr, (const bf16_t*)(ws + WS_WO), nullptr, nullptr, 0, D, D, D, 0};
            hipLaunchKernelGGL(ngemm<NEpiResid>, dim3(D / 64, T / 64), dim3(256), 0, stream, g2, NEpiResid{p.in[0], p.in[11], mod + 2 * 1024, Z}); } break;
        case 5: hipLaunchKernelGGL(k_ln_router, dim3(256), dim3(512), 36 * 1024 * 4, stream, KA{p, (const float*)Z, X1, l, 0}); break;
        case 6: { hipLaunchKernelGGL(k_moe_prep, dim3(1), dim3(256), 0, stream, KA{p, nullptr, nullptr, l, 0});
            NG g3{H, rowmap, (const bf16_t*)(ws + WS_WGU) + (size_t)l * 32 * 512 * 1024, te, nt, (size_t)512 * 1024, D, D, D, 0};
            hipLaunchKernelGGL(ngemm<NEpiF32>, dim3(512 / 64, MPAD / 64), dim3(256), 0, stream, g3, NEpiF32{(float*)(ws + WS_RA + RA_GURAW), 512, 0});
            hipLaunchKernelGGL(k_moe1_post, dim3(MPAD), dim3(256), 0, stream, KA{p, nullptr, nullptr, l, 0}); } break;
        case 7: { hipLaunchKernelGGL(k_moe_prep, dim3(1), dim3(256), 0, stream, KA{p, nullptr, nullptr, l, 0});
            NG g4{(const bf16_t*)(ws + WS_RA + RA_ACT), nullptr, (const bf16_t*)(ws + WS_WD) + (size_t)l * 32 * 1024 * 256, te, nt, (size_t)1024 * 256, EFF, EFF, EFF, 0};
            hipLaunchKernelGGL(ngemm<NEpiMoe2>, dim3(D / 64, MPAD / 64), dim3(256), 0, stream, g4, NEpiMoe2{rowmap, (bf16_t*)(ws + WS_RA + RA_Y2)}); } break;
        case 8: hipLaunchKernelGGL(k_ln2, dim3(256), dim3(512), 0, stream, KA{p, (const float*)X1, l == 0 ? X2 : p.out, l, l == 0 ? 1 : -1}); break;
        case 9: { NG g{H, nullptr, (const bf16_t*)(ws + WS_WIN), nullptr, nullptr, 0, D, D, D, 0};
            hipLaunchKernelGGL(ngemm<NEpiGelu>, dim3(4096 / 64, T / 64), dim3(256), 0, stream, g, NEpiGelu{p.in[13], (bf16_t*)(ws + WS_RA + RA_U), (bf16_t*)(ws + WS_RA + RA_V2)});
            hipLaunchKernelGGL(k_vstat_naive, dim3(T / 4), dim3(256), 0, stream, p); } break;
        case 10: { if (FAST[9]) hipLaunchKernelGGL(k_vstat_bridge, dim3(T / 256), dim3(256), 0, stream, p);
            hipLaunchKernelGGL(k_gate_naive, dim3(T * GW / 256), dim3(256), 0, stream, p); } break;
        case 11: { NG g2{(const bf16_t*)(ws + WS_RA + RA_GATED), nullptr, (const bf16_t*)(ws + WS_WOUT), nullptr, nullptr, 0, GW, GW, GW, 0};
            hipLaunchKernelGGL(ngemm<NEpiResid>, dim3(D / 64, T / 64), dim3(256), 0, stream, g2, NEpiResid{X2, p.in[19], mod + 2 * 6144 + 2 * 1024, Z}); } break;
        }
        ++k;
    }
}
```

```cpp
#include <hip/hip_runtime.h>
#include <cstdio>
#include <cstdint>

typedef unsigned short bf16_t;
typedef unsigned u32x4 __attribute__((ext_vector_type(4)));
typedef unsigned u32x2 __attribute__((ext_vector_type(2)));
typedef float f32x4 __attribute__((ext_vector_type(4)));
typedef float f32x2v __attribute__((ext_vector_type(2)));

constexpr int T = 16384, D = 1024, SEQ = 8192;
constexpr int NQKV = 1536, GW = 2048  , NEXP = 32, EFF = 256;
constexpr float LN_EPS = 1e-5f, ALPHA = 1.4142135623730951f;
constexpr float QSCALE = 0.125f * 1.4426950408889634f;
constexpr float LOG2E = 1.4426950408889634f;
constexpr int MAXTILES = 160, MPAD = MAXTILES * 256;

constexpr size_t MiB = 1u << 20;
constexpr size_t WS_CTL = 0;
constexpr size_t WS_MOD = 64 * 1024;
constexpr size_t WS_ROPE_C = 1 * MiB, WS_ROPE_S = 3 * MiB;
constexpr size_t WS_WS = 5 * MiB;
constexpr size_t WS_VSTAT = 6 * MiB;
constexpr size_t WS_LIST = 10 * MiB;
constexpr size_t WS_WL = 14 * MiB;
constexpr size_t WS_TAB = 18 * MiB;
constexpr size_t WS_ROWSTAT = 19 * MiB;
constexpr size_t WS_WQKV = 20 * MiB, WS_WO = 23 * MiB, WS_WIN = 25 * MiB, WS_WOUT = 33 * MiB, WS_WGU = 37 * MiB, WS_WD = 101 * MiB;
constexpr size_t WS_H = 133 * MiB, WS_X1 = 165 * MiB, WS_X2 = 229 * MiB, WS_RA = 293 * MiB, WS_END = 485 * MiB;
constexpr size_t RA_Q = 0, RA_K = 32 * MiB, RA_V = 40 * MiB, RA_O = 48 * MiB, RA_QKVRAW = 80 * MiB;
constexpr size_t RA_U = 0, RA_V2 = 64 * MiB, RA_GATED = 128 * MiB;
constexpr size_t RA_Y2 = 0, RA_ACT = 64 * MiB, RA_GURAW = 84 * MiB;

struct Params {
    const float* in[26];
    float* out;
    unsigned char* ws;
};
struct KA { Params p; const float* a; float* b; int i0, i1; };

__device__ __forceinline__ unsigned f2bf(float f) { unsigned u = __builtin_bit_cast(unsigned, f); return (u + 0x7fffu + ((u >> 16) & 1u)) >> 16; }
__device__ __forceinline__ unsigned pk2(float lo, float hi) { return f2bf(lo) | (f2bf(hi) << 16); }
__device__ __forceinline__ float bf2f(bf16_t v) { return __builtin_bit_cast(float, (unsigned)v << 16); }
__device__ __forceinline__ float wave_sum(float v) {
#pragma unroll
    for (int o = 1; o < 64; o <<= 1) v += __shfl_xor(v, o);
    return v;
}
__device__ __forceinline__ float wave_max(float v) {
#pragma unroll
    for (int o = 1; o < 64; o <<= 1) v = fmaxf(v, __shfl_xor(v, o));
    return v;
}
__device__ __forceinline__ float silu_f(float v) { return v / (1.f + expf(-v)); }

__device__ __forceinline__ int slot_qkv(int n) {
    int tile, hl, d;
    if (n < 1024) { const int head = n >> 6; d = n & 63; tile = head >> 2; hl = head & 3; }
    else if (n < 1280) { const int m = n - 1024; tile = 4; hl = m >> 6; d = m & 63; }
    else { const int m = n - 1280; tile = 5; hl = m >> 6; d = m & 63; }
    return tile * 256 + (d >> 5) * 128 + hl * 32 + (d & 31);
}
__device__ __forceinline__ int slot_gu(int n) {
    const int up = n >> 8, c = n & 255, pn = c >> 7; return pn * 256 + up * 128 + (c & 127);
}

__device__ __forceinline__ int fresh_tid() { int t = threadIdx.x; asm volatile("" : "+v"(t)); return t; }

__device__ __forceinline__ void mods_item(int tid, int item, const float* c, const float* ada_w, const float* ada_b, float* mod, float* lds) {
    const int wave = tid >> 6, lane = tid & 63;
    const int l = item / 96, cg = item % 96;
    const float* W = ada_w + (size_t)l * 1024 * 6144 + cg * 64 + lane;
    float a0 = 0.f, a1 = 0.f;
    const int kb = wave * 128;
#pragma unroll 8
    for (int k = 0; k < 128; ++k) {
        const float w = W[(size_t)(kb + k) * 6144];
        a0 += silu_f(c[kb + k]) * w; a1 += silu_f(c[1024 + kb + k]) * w;
    }
    lds[(wave * 2 + 0) * 64 + lane] = a0; lds[(wave * 2 + 1) * 64 + lane] = a1;
    __syncthreads();
    if (tid < 128) { const int b = tid >> 6; float s = 0.f;
#pragma unroll
        for (int w = 0; w < 8; ++w) s += lds[(w * 2 + b) * 64 + lane];
        mod[(size_t)(l * 2 + b) * 6144 + cg * 64 + lane] = s + ada_b[l * 6144 + cg * 64 + lane]; }
    __syncthreads();
}
__device__ __forceinline__ void conv_item(const float* src, int K, int N, bf16_t* dst, int map, int item, int lane) {
    const int nblk = N >> 6, kb = item / nblk, nb = item % nblk, k0 = kb * 32, n = nb * 64 + lane;
    const float* s = src + (size_t)k0 * N + n;
    float v[32];
#pragma unroll
    for (int t = 0; t < 32; ++t) v[t] = s[(size_t)t * N];
    const int slot = map == 1 ? slot_qkv(n) : (map == 2 ? slot_gu(n) : n);
    u32x4* d = (u32x4*)(dst + (size_t)slot * K + k0);
#pragma unroll
    for (int j = 0; j < 4; ++j) { u32x4 o; o.x = pk2(v[8 * j], v[8 * j + 1]); o.y = pk2(v[8 * j + 2], v[8 * j + 3]); o.z = pk2(v[8 * j + 4], v[8 * j + 5]); o.w = pk2(v[8 * j + 6], v[8 * j + 7]); d[j] = o; }
}
constexpr int CI_QKV = 32 * 24, CI_WO = 32 * 16, CI_WIN = 32 * 64, CI_WOUT = 64 * 16, CI_GU1 = 32 * 8, CI_GU = 64 * CI_GU1, CI_DN1 = 8 * 16, CI_DN = 64 * CI_DN1;
constexpr int CI_TOTAL = CI_QKV + CI_WO + CI_WIN + CI_WOUT + CI_GU + CI_DN;

__device__ __forceinline__ void p0_prologue(const Params& p, int wg, int nwg, float* lds) {
    const int tid = fresh_tid(), wave = tid >> 6, lane = tid & 63;
    unsigned char* ws = p.ws;
    for (int it = wg; it < 192; it += nwg) mods_item(tid, it, p.in[1], p.in[3], p.in[4], (float*)(ws + WS_MOD), lds);
    const int gw = wg * 8 + wave, ngw = nwg * 8;
    for (int it = gw; it < CI_TOTAL; it += ngw) {
        int r = it;
        if (r < CI_QKV) { conv_item(p.in[7], 1024, 1536, (bf16_t*)(ws + WS_WQKV), 1, r, lane); continue; } r -= CI_QKV;
        if (r < CI_WO) { conv_item(p.in[10], 1024, 1024, (bf16_t*)(ws + WS_WO), 0, r, lane); continue; } r -= CI_WO;
        if (r < CI_WIN) { conv_item(p.in[12], 1024, 4096, (bf16_t*)(ws + WS_WIN), 0, r, lane); continue; } r -= CI_WIN;
        if (r < CI_WOUT) { conv_item(p.in[18], 2048, 1024, (bf16_t*)(ws + WS_WOUT), 0, r, lane); continue; } r -= CI_WOUT;
        if (r < CI_GU) { const int mtx = r / CI_GU1; conv_item(p.in[24] + (size_t)mtx * 1024 * 512, 1024, 512, (bf16_t*)(ws + WS_WGU) + (size_t)mtx * 512 * 1024, 2, r % CI_GU1, lane); continue; } r -= CI_GU;
        { const int mtx = r / CI_DN1; conv_item(p.in[25] + (size_t)mtx * 256 * 1024, 256, 1024, (bf16_t*)(ws + WS_WD) + (size_t)mtx * 1024 * 256, 0, r % CI_DN1, lane); }
    }
    const int gt = wg * 512 + tid, ngt = nwg * 512;
    for (int i = gt; i < 8 * 128 * 128; i += ngt) { const int t = (i >> 7) & 127, s = i & 127; ((bf16_t*)(ws + WS_WS))[i] = (bf16_t)f2bf(s <= t ? p.in[16][i] : 0.f); }
    const int* pos = (const int*)p.in[2];
    for (int i = gt; i < T * 32; i += ngt) {
        const int row = i >> 5, j = i & 31;
        double f = 1.0;
        for (int q = 0; q < j; ++q) f *= 0.7498942093324558;
        const double rev = (double)pos[row] * f * 0.15915494309189535;
        const float fr = (float)(rev - floor(rev));
        ((float*)(ws + WS_ROPE_C))[i] = __builtin_amdgcn_cosf(fr);
        ((float*)(ws + WS_ROPE_S))[i] = __builtin_amdgcn_sinf(fr);
    }
}

__device__ __forceinline__ void phase_h0(const Params& p, int wg, int nwg) {
    const int tid = fresh_tid(), lane = tid & 63, gw = wg * 8 + (tid >> 6), ngw = nwg * 8;
    const float* x = p.in[0]; const float* mod = (const float*)(p.ws + WS_MOD); bf16_t* H = (bf16_t*)(p.ws + WS_H);
    for (int row = gw; row < T; row += ngw) {
        const int b = row >> 13; const float* sh = mod + (size_t)(0 * 2 + b) * 6144; const float* sc = sh + 1024;
#pragma unroll
        for (int j = 0; j < 4; ++j) { const int col = 4 * lane + 256 * j;
            const f32x4 xv = *(const f32x4*)(x + (size_t)row * D + col), s = *(const f32x4*)(sc + col), h = *(const f32x4*)(sh + col);
            const f32x4 o = xv * (s + 1.0f) + h; u32x2 w; w.x = pk2(o.x, o.y); w.y = pk2(o.z, o.w); *(u32x2*)(H + (size_t)row * D + col) = w; }
    }
}
__device__ __forceinline__ void phase_ln_router(const Params& p, int l, const float* z, float* xo, int wg, int nwg, float* lds, bool append = true) {
    const int tid = fresh_tid(), wave = tid >> 6, lane = tid & 63;
    const float* wgr = p.in[20] + (size_t)l * 1024 * 4; const float* bgr = p.in[21] + l * 4;
    const float* wer = p.in[22] + (size_t)l * 1024 * 32; const float* ber = p.in[23] + l * 32;
#pragma unroll 1
    for (int o = 0; o < 36; ++o)
        for (int k = tid; k < 1024; k += 512) lds[o * 1024 + k] = o < 4 ? wgr[k * 4 + o] : wer[k * 32 + (o - 4)];
    __syncthreads();
    const float* lg = p.in[5] + (size_t)(l * 2 + 0) * D; const float* lb = p.in[6] + (size_t)(l * 2 + 0) * D;
    const float* mod = (const float*)(p.ws + WS_MOD); bf16_t* H = (bf16_t*)(p.ws + WS_H);
    int* cnt = (int*)(p.ws + WS_CTL) + l * 32; int* list = (int*)(p.ws + WS_LIST) + (size_t)l * 32 * T; float* wl = (float*)(p.ws + WS_WL) + (size_t)l * 32 * T;
    const int gw = wg * 8 + wave, ngw = nwg * 8;
#pragma unroll 1
    for (int row = gw; row < T; row += ngw) {
        const int b = row >> 13; const float* sh = mod + (size_t)(l * 2 + b) * 6144 + 3 * 1024; const float* sc = sh + 1024;
        f32x4 v[4]; float s = 0.f;
#pragma unroll
        for (int j = 0; j < 4; ++j) { v[j] = *(const f32x4*)(z + (size_t)row * D + 4 * lane + 256 * j); s += (v[j].x + v[j].y) + (v[j].z + v[j].w); }
        const float mean = wave_sum(s) * (1.f / D); float s2 = 0.f;
#pragma unroll
        for (int j = 0; j < 4; ++j) { v[j] = v[j] - mean; s2 += (v[j].x * v[j].x + v[j].y * v[j].y) + (v[j].z * v[j].z + v[j].w * v[j].w); }
        const float rstd = 1.f / sqrtf(wave_sum(s2) * (1.f / D) + LN_EPS);
        f32x4 h[4];
#pragma unroll
        for (int j = 0; j < 4; ++j) { const int col = 4 * lane + 256 * j;
            const f32x4 x1 = v[j] * rstd * *(const f32x4*)(lg + col) + *(const f32x4*)(lb + col);
            *(f32x4*)(xo + (size_t)row * D + col) = x1;
            h[j] = x1 * (*(const f32x4*)(sc + col) + 1.0f) + *(const f32x4*)(sh + col);
            u32x2 w; w.x = pk2(h[j].x, h[j].y); w.y = pk2(h[j].z, h[j].w); *(u32x2*)(H + (size_t)row * D + col) = w; }
        float gl[4];
#pragma unroll
        for (int o = 0; o < 4; ++o) { float a = 0.f;
#pragma unroll
            for (int j = 0; j < 4; ++j) { const f32x4 w = *(const f32x4*)(lds + o * 1024 + 4 * lane + 256 * j); a += (h[j].x * w.x + h[j].y * w.y) + (h[j].z * w.z + h[j].w * w.w); }
            gl[o] = wave_sum(a) + bgr[o]; }
        int g = 0; float gm = gl[0];
#pragma unroll
        for (int o = 1; o < 4; ++o) if (gl[o] > gm) { gm = gl[o]; g = o; }
        float gs = 0.f;
#pragma unroll
        for (int o = 0; o < 4; ++o) gs += expf(gl[o] - gm);
        const float gp = 1.f / gs;
        g = __builtin_amdgcn_readfirstlane(g);
        float v0 = -INFINITY, v1 = -INFINITY; int e0 = 0, e1 = 0;
#pragma unroll 2
        for (int e = 0; e < 8; ++e) { float a = 0.f; const float* wrow = lds + (4 + g * 8 + e) * 1024;
#pragma unroll
            for (int j = 0; j < 4; ++j) { const f32x4 w = *(const f32x4*)(wrow + 4 * lane + 256 * j); a += (h[j].x * w.x + h[j].y * w.y) + (h[j].z * w.z + h[j].w * w.w); }
            const float val = wave_sum(a) + ber[g * 8 + e];
            if (val > v0) { v1 = v0; e1 = e0; v0 = val; e0 = e; } else if (val > v1) { v1 = val; e1 = e; } }
        const float w0 = 1.f / (1.f + expf(v1 - v0)), w1 = 1.f - w0;
        if (lane == 0 && append) {
            const int ea = g * 8 + e0, eb = g * 8 + e1;
            const int pa = atomicAdd(cnt + ea, 1); list[(size_t)ea * T + pa] = row * 2 + 0; wl[(size_t)ea * T + pa] = w0 * gp;
            const int pb = atomicAdd(cnt + eb, 1); list[(size_t)eb * T + pb] = row * 2 + 1; wl[(size_t)eb * T + pb] = w1 * gp;
        }
    }
}
__device__ __forceinline__ void phase_ln2(const Params& p, int l, const float* x1, float* xo, int nextl, int wg, int nwg) {
    const int tid = fresh_tid(), lane = tid & 63, gw = wg * 8 + (tid >> 6), ngw = nwg * 8;
    const float* lg = p.in[5] + (size_t)(l * 2 + 1) * D; const float* lb = p.in[6] + (size_t)(l * 2 + 1) * D;
    const float* mod = (const float*)(p.ws + WS_MOD); bf16_t* H = (bf16_t*)(p.ws + WS_H); const bf16_t* y2 = (const bf16_t*)(p.ws + WS_RA + RA_Y2);
    for (int row = gw; row < T; row += ngw) {
        const int b = row >> 13; const float* gt = mod + (size_t)(l * 2 + b) * 6144 + 5 * 1024;
        f32x4 v[4]; float s = 0.f;
#pragma unroll
        for (int j = 0; j < 4; ++j) { const int col = 4 * lane + 256 * j;
            const f32x4 xv = *(const f32x4*)(x1 + (size_t)row * D + col), g = *(const f32x4*)(gt + col);
            const u32x2 ya = *(const u32x2*)(y2 + ((size_t)row * 2 + 0) * D + col), yb = *(const u32x2*)(y2 + ((size_t)row * 2 + 1) * D + col);
            f32x4 y; y.x = __builtin_bit_cast(float, ya.x << 16) + __builtin_bit_cast(float, yb.x << 16); y.y = __builtin_bit_cast(float, ya.x & 0xffff0000u) + __builtin_bit_cast(float, yb.x & 0xffff0000u);
            y.z = __builtin_bit_cast(float, ya.y << 16) + __builtin_bit_cast(float, yb.y << 16); y.w = __builtin_bit_cast(float, ya.y & 0xffff0000u) + __builtin_bit_cast(float, yb.y & 0xffff0000u);
            v[j] = xv * ALPHA + (g + 1.0f) * y; s += (v[j].x + v[j].y) + (v[j].z + v[j].w); }
        const float mean = wave_sum(s) * (1.f / D); float s2 = 0.f;
#pragma unroll
        for (int j = 0; j < 4; ++j) { v[j] = v[j] - mean; s2 += (v[j].x * v[j].x + v[j].y * v[j].y) + (v[j].z * v[j].z + v[j].w * v[j].w); }
        const float rstd = 1.f / sqrtf(wave_sum(s2) * (1.f / D) + LN_EPS);
        const float* sh = mod + (size_t)((nextl < 0 ? 0 : nextl) * 2 + b) * 6144; const float* sc = sh + 1024;
#pragma unroll
        for (int j = 0; j < 4; ++j) { const int col = 4 * lane + 256 * j;
            const f32x4 x2 = v[j] * rstd * *(const f32x4*)(lg + col) + *(const f32x4*)(lb + col);
            *(f32x4*)(xo + (size_t)row * D + col) = x2;
            if (nextl >= 0) { const f32x4 h = x2 * (*(const f32x4*)(sc + col) + 1.0f) + *(const f32x4*)(sh + col);
                u32x2 w; w.x = pk2(h.x, h.y); w.y = pk2(h.z, h.w); *(u32x2*)(H + (size_t)row * D + col) = w; } }
    }
}

__global__ void __launch_bounds__(512) k_prologue(Params p) { __shared__ float lds[1024]; p0_prologue(p, blockIdx.x, gridDim.x, lds); }
__global__ void __launch_bounds__(512) k_h0(Params p) { phase_h0(p, blockIdx.x, gridDim.x); }
__global__ void __launch_bounds__(512) k_ln_router(KA a) { extern __shared__ float dl[]; phase_ln_router(a.p, a.i0, a.a, a.b, blockIdx.x, gridDim.x, dl); }
__global__ void __launch_bounds__(512) k_ln2(KA a) { phase_ln2(a.p, a.i0, a.a, a.b, a.i1, blockIdx.x, gridDim.x); }

struct NG { const bf16_t* A; const int* rowmap; const bf16_t* Bt; const int* tile_expert; const int* ntiles; size_t estride; int lda, ldb, K, pad; };
template <class Epi> __global__ void __launch_bounds__(256) ngemm(NG g, Epi E) {
    __shared__ float As[16][68], Bs[16][68];
    const int tid = threadIdx.x, tx = tid & 15, ty = tid >> 4;
    const int m0 = blockIdx.y * 64, n0 = blockIdx.x * 64;
    const bf16_t* Bt = g.Bt;
    if (g.tile_expert) { if ((m0 >> 8) >= *g.ntiles) return; Bt += (size_t)g.tile_expert[m0 >> 8] * g.estride; }
    const int lr = tid >> 2, kq = tid & 3;
    int arow = m0 + lr; if (g.rowmap) { const int rm = g.rowmap[arow]; arow = rm < 0 ? 0 : (rm >> 1); }
    const bf16_t* ap = g.A + (size_t)arow * g.lda + kq * 4; const bf16_t* bp = Bt + (size_t)(n0 + lr) * g.ldb + kq * 4;
    float acc[4][4];
#pragma unroll
    for (int i = 0; i < 4; ++i)
#pragma unroll
        for (int j = 0; j < 4; ++j) acc[i][j] = 0.f;
    for (int k0 = 0; k0 < g.K; k0 += 16) {
        const u32x2 av = *(const u32x2*)(ap + k0), bv = *(const u32x2*)(bp + k0);
        __syncthreads();
        As[kq * 4 + 0][lr] = __builtin_bit_cast(float, av.x << 16); As[kq * 4 + 1][lr] = __builtin_bit_cast(float, av.x & 0xffff0000u);
        As[kq * 4 + 2][lr] = __builtin_bit_cast(float, av.y << 16); As[kq * 4 + 3][lr] = __builtin_bit_cast(float, av.y & 0xffff0000u);
        Bs[kq * 4 + 0][lr] = __builtin_bit_cast(float, bv.x << 16); Bs[kq * 4 + 1][lr] = __builtin_bit_cast(float, bv.x & 0xffff0000u);
        Bs[kq * 4 + 2][lr] = __builtin_bit_cast(float, bv.y << 16); Bs[kq * 4 + 3][lr] = __builtin_bit_cast(float, bv.y & 0xffff0000u);
        __syncthreads();
#pragma unroll
        for (int k = 0; k < 16; ++k) {
            const f32x4 a = *(const f32x4*)&As[k][ty * 4], b = *(const f32x4*)&Bs[k][tx * 4];
#pragma unroll
            for (int i = 0; i < 4; ++i)
#pragma unroll
                for (int j = 0; j < 4; ++j) acc[i][j] += a[i] * b[j];
        }
    }
#pragma unroll
    for (int i = 0; i < 4; ++i)
#pragma unroll
        for (int j = 0; j < 4; ++j) E(m0 + ty * 4 + i, n0 + tx * 4 + j, acc[i][j]);
}
struct NEpiF32 { float* C; int ldc, pad; __device__ void operator()(int r, int c, float v) const { C[(size_t)r * ldc + c] = v; } };
struct NEpiResid { const float* x; const float* bias; const float* gt  ; float* z;
    __device__ void operator()(int r, int c, float v) const { const int b = r >> 13; z[(size_t)r * D + c] = ALPHA * x[(size_t)r * D + c] + (1.f + gt[b * 6144 + c]) * (v + bias[c]); } };
struct NEpiGelu { const float* bias; bf16_t* U; bf16_t* V;
    __device__ void operator()(int r, int c, float v) const { const float a = v + bias[c]; const float g = 0.5f * a * (1.f + erff(a * 0.70710678118654752f));
        if (c < GW) U[(size_t)r * GW + c] = (bf16_t)f2bf(g); else V[(size_t)r * GW + c - GW] = (bf16_t)f2bf(g); } };
struct NEpiMoe2 { const int* rowmap; bf16_t* y2; __device__ void operator()(int r, int c, float v) const { const int rm = rowmap[r]; if (rm >= 0) y2[(size_t)rm * D + c] = (bf16_t)f2bf(v); } };

__global__ void k_rope_post(Params p) {
    const size_t i = (size_t)blockIdx.x * 256 + threadIdx.x; if (i >= (size_t)T * 768) return;
    const int row = (int)(i / 768), q = (int)(i % 768);
    const int tile = q / 128, hl = (q % 128) / 32, dp = q % 32;
    const float* raw = (const float*)(p.ws + WS_RA + RA_QKVRAW) + (size_t)row * NQKV + tile * 256;
    const float* bq = p.in[8];
    int scol; bf16_t* dst; float sc = 1.f; int ld;
    if (tile < 4) { scol = (tile * 4 + hl) * 64; dst = (bf16_t*)(p.ws + WS_RA + RA_Q) + (size_t)row * 1024 + scol; sc = QSCALE; }
    else if (tile == 4) { scol = 1024 + hl * 64; dst = (bf16_t*)(p.ws + WS_RA + RA_K) + (size_t)row * 256 + hl * 64; }
    else { scol = 1280 + hl * 64; dst = (bf16_t*)(p.ws + WS_RA + RA_V) + (size_t)row * 256 + hl * 64; }
    const float x1 = raw[hl * 32 + dp] + bq[scol + dp], x2 = raw[128 + hl * 32 + dp] + bq[scol + 32 + dp];
    float o1 = x1, o2 = x2;
    if (tile < 5) { const float cs = ((const float*)(p.ws + WS_ROPE_C))[(size_t)row * 32 + dp], sn = ((const float*)(p.ws + WS_ROPE_S))[(size_t)row * 32 + dp];
        o1 = x1 * cs - x2 * sn; o2 = x2 * cs + x1 * sn; }
    dst[dp] = (bf16_t)f2bf(o1 * sc); dst[32 + dp] = (bf16_t)f2bf(o2 * sc);
    (void)ld;
}
__global__ void __launch_bounds__(256) k_attn_naive(Params p) {
    const int w = blockIdx.x * 4 + (threadIdx.x >> 6), lane = threadIdx.x & 63;
    const int row = w >> 4, hq = w & 15, kvh = hq >> 2, s = row & (SEQ - 1);
    const bf16_t* Q = (const bf16_t*)(p.ws + WS_RA + RA_Q) + (size_t)row * 1024 + hq * 64;
    const bf16_t* Kb = (const bf16_t*)(p.ws + WS_RA + RA_K); const bf16_t* Vb = (const bf16_t*)(p.ws + WS_RA + RA_V);
    float q[64];
#pragma unroll
    for (int i = 0; i < 8; ++i) { const u32x4 v = *(const u32x4*)(Q + i * 8);
        q[8 * i] = __builtin_bit_cast(float, v.x << 16); q[8 * i + 1] = __builtin_bit_cast(float, v.x & 0xffff0000u); q[8 * i + 2] = __builtin_bit_cast(float, v.y << 16); q[8 * i + 3] = __builtin_bit_cast(float, v.y & 0xffff0000u);
        q[8 * i + 4] = __builtin_bit_cast(float, v.z << 16); q[8 * i + 5] = __builtin_bit_cast(float, v.z & 0xffff0000u); q[8 * i + 6] = __builtin_bit_cast(float, v.w << 16); q[8 * i + 7] = __builtin_bit_cast(float, v.w & 0xffff0000u); }
    float sc[2];
#pragma unroll
    for (int h = 0; h < 2; ++h) { const int ks = s - 127 + h * 64 + lane; float a = -INFINITY;
        if (ks >= 0) { const bf16_t* kr = Kb + (size_t)(row - s + ks) * 256 + kvh * 64; a = 0.f;
#pragma unroll
            for (int i = 0; i < 8; ++i) { const u32x4 v = *(const u32x4*)(kr + i * 8);
                a += q[8 * i] * __builtin_bit_cast(float, v.x << 16) + q[8 * i + 1] * __builtin_bit_cast(float, v.x & 0xffff0000u) + q[8 * i + 2] * __builtin_bit_cast(float, v.y << 16) + q[8 * i + 3] * __builtin_bit_cast(float, v.y & 0xffff0000u)
                   + q[8 * i + 4] * __builtin_bit_cast(float, v.z << 16) + q[8 * i + 5] * __builtin_bit_cast(float, v.z & 0xffff0000u) + q[8 * i + 6] * __builtin_bit_cast(float, v.w << 16) + q[8 * i + 7] * __builtin_bit_cast(float, v.w & 0xffff0000u); } }
        sc[h] = a; }
    const float sink = p.in[9][hq] * LOG2E;
    const float m = fmaxf(wave_max(fmaxf(sc[0], sc[1])), sink);
    const float p0 = exp2f(sc[0] - m), p1 = exp2f(sc[1] - m);
    const float den = wave_sum(p0 + p1) + exp2f(sink - m);
    float o = 0.f;
    for (int j = 0; j < 64; ++j) {
        const float a0 = __shfl(p0, j), a1 = __shfl(p1, j);
        const int k0 = s - 127 + j, k1 = s - 63 + j;
        if (k0 >= 0) o += a0 * bf2f(Vb[(size_t)(row - s + k0) * 256 + kvh * 64 + lane]);
        if (k1 >= 0) o += a1 * bf2f(Vb[(size_t)(row - s + k1) * 256 + kvh * 64 + lane]);
    }
    ((bf16_t*)(p.ws + WS_RA + RA_O))[(size_t)row * 1024 + hq * 64 + lane] = (bf16_t)f2bf(o / den);
}
__global__ void __launch_bounds__(256) k_vstat_naive(Params p) {
    const int row = blockIdx.x * 4 + (threadIdx.x >> 6), lane = threadIdx.x & 63;
    const bf16_t* v = (const bf16_t*)(p.ws + WS_RA + RA_V2) + (size_t)row * GW;
    float s = 0.f, s2 = 0.f;
    for (int i = lane; i < GW; i += 64) { const float a = bf2f(v[i]); s += a; s2 += a * a; }
    s = wave_sum(s); s2 = wave_sum(s2);
    const float mean = s * (1.f / GW), var = fmaxf(s2 * (1.f / GW) - mean * mean, 0.f);
    if (lane == 0) { float* rs = (float*)(p.ws + WS_ROWSTAT) + (size_t)row * 2; rs[0] = mean; rs[1] = 1.f / sqrtf(var + LN_EPS); }
    if (lane < 32) { f32x2v o; o.x = lane == 0 ? s : 0.f; o.y = lane == 0 ? s2 : 0.f; *(f32x2v*)((float*)(p.ws + WS_VSTAT) + ((size_t)row * 32 + lane) * 2) = o; }
}
__global__ void __launch_bounds__(256) k_vstat_bridge(Params p) {
    const int row = blockIdx.x * 256 + threadIdx.x; const float* ps = (const float*)(p.ws + WS_VSTAT) + (size_t)row * 64;
    float s = 0.f, s2 = 0.f;
    for (int i = 0; i < 32; ++i) { s += ps[2 * i]; s2 += ps[2 * i + 1]; }
    const float mean = s * (1.f / GW), var = fmaxf(s2 * (1.f / GW) - mean * mean, 0.f);
    float* rs = (float*)(p.ws + WS_ROWSTAT) + (size_t)row * 2; rs[0] = mean; rs[1] = 1.f / sqrtf(var + LN_EPS);
}
__global__ void __launch_bounds__(256) k_gate_naive(Params p) {
    const size_t i = (size_t)blockIdx.x * 256 + threadIdx.x;
    const int t = (int)(i >> 11), c = (int)(i & 2047), tt = t & 127, t0 = t - tt, g = c >> 8;
    const bf16_t* v = (const bf16_t*)(p.ws + WS_RA + RA_V2); const bf16_t* u = (const bf16_t*)(p.ws + WS_RA + RA_U);
    const bf16_t* w = (const bf16_t*)(p.ws + WS_WS) + (size_t)(g * 128 + tt) * 128; const float* rs = (const float*)(p.ws + WS_ROWSTAT);
    const float lg = p.in[14][c], lb = p.in[15][c];
    float a = 0.f;
    for (int s = 0; s <= tt; ++s) { const float vn = (bf2f(v[(size_t)(t0 + s) * GW + c]) - rs[(size_t)(t0 + s) * 2]) * rs[(size_t)(t0 + s) * 2 + 1] * lg + lb; a += bf2f(w[s]) * vn; }
    a += p.in[17][g * 128 + tt];
    ((bf16_t*)(p.ws + WS_RA + RA_GATED))[i] = (bf16_t)f2bf(bf2f(u[i]) * a);
}
__global__ void __launch_bounds__(256) k_moe_prep(KA ka) {
    const Params& p = ka.p; const int l = ka.i0;
    __shared__ int tb[33];
    const int* cnt = (const int*)(p.ws + WS_CTL) + l * 32; const int* list = (const int*)(p.ws + WS_LIST) + (size_t)l * 32 * T; const float* wl = (const float*)(p.ws + WS_WL) + (size_t)l * 32 * T;
    int* rowmap = (int*)(p.ws + WS_TAB); float* wrow = (float*)(p.ws + WS_TAB) + MPAD; int* te = (int*)(p.ws + WS_TAB) + 2 * MPAD; int* nt = (int*)(p.ws + WS_CTL) + 64 + l;
    if (threadIdx.x == 0) { int a = 0; for (int e = 0; e < 32; ++e) { tb[e] = a; a += (cnt[e] + 255) >> 8; } tb[32] = a; *nt = a; }
    __syncthreads();
    for (int e = 0; e < 32; ++e) {
        const int n = cnt[e];
        for (int tl = tb[e]; tl < tb[e + 1]; ++tl) { if (threadIdx.x == 0) te[tl] = e;
            const int idx = (tl - tb[e]) * 256 + threadIdx.x; rowmap[tl * 256 + threadIdx.x] = idx < n ? list[(size_t)e * T + idx] : -1; wrow[tl * 256 + threadIdx.x] = idx < n ? wl[(size_t)e * T + idx] : 0.f; }
    }
}
__global__ void __launch_bounds__(256) k_moe1_post(KA ka) {
    const Params& p = ka.p; const int l = ka.i0;
    const size_t i = (size_t)blockIdx.x * 256 + threadIdx.x; const int m = (int)(i >> 8), c = (int)(i & 255);
    const int nt = ((const int*)(p.ws + WS_CTL))[64 + l]; if (m >= nt * 256) return;
    const float* gu = (const float*)(p.ws + WS_RA + RA_GURAW) + (size_t)m * 512; const float w = ((const float*)(p.ws + WS_TAB))[MPAD + m];
    const int pn = c >> 7, j = c & 127; const float g = gu[pn * 256 + j], u = gu[pn * 256 + 128 + j];
    ((bf16_t*)(p.ws + WS_RA + RA_ACT))[i] = (bf16_t)f2bf(silu_f(g) * u * w);
}


namespace pg8 {
#define PG8_LAS __attribute__((address_space(3)))
typedef short bf16x8 __attribute__((ext_vector_type(8)));
typedef float f32x2 __attribute__((ext_vector_type(2)));
constexpr int BM = 256, BK = 64, HALF = 128, HTB = HALF * BK * 2  , STAGE_BYTES = 8 * HTB, NXCD = 8, WGM = 8;

__host__ __device__ __forceinline__ int lds_byte(int r, int c) { const int st = (r >> 4) * 2 + (c >> 5), rr = r & 15, cc = c & 31, ob = rr * 64 + cc * 2; return st * 1024 + (ob ^ (((ob >> 9) & 1) << 5)); }
__host__ __device__ __forceinline__ void stage_rc(int b, int& R, int& C) { const int st = b / 1024, sb = b % 1024, swz = sb ^ (((sb >> 9) & 1) << 5); R = (st >> 1) * 16 + swz / 64; C = (st & 1) * 32 + (swz % 64) / 2; }
__host__ __device__ __forceinline__ int perm32(int rho) { const int n = rho >> 4, i = rho & 15; return 8 * (i >> 2) + 4 * n + (i & 3); }

struct Unit { int pm, pn; };
struct Gemm { const bf16_t* A; const bf16_t* Bt; int lda, ldb, K; };

struct StaticOrder {
    static constexpr bool GATHER = false;
    int nM, nN, nwg, G, c;
    __device__ void init(int M, int N, int G_, int c_) { nM = M / BM; nN = N / BM; nwg = nM * nN; G = G_; c = c_; }
    __device__ bool next(int i, Unit& u) const {
        const long L = (long)i * G + c; if (L >= nwg) return false;
        int wgid = (int)L; { const int q = nwg / NXCD, r = nwg % NXCD, xcd = wgid % NXCD, off = wgid / NXCD; wgid = (xcd < r ? xcd * (q + 1) : r * (q + 1) + (xcd - r) * q) + off; }
        const int nig = WGM * nN, gid = wgid / nig, fm = gid * WGM, gsz = (nM - fm) < WGM ? (nM - fm) : WGM;
        u.pm = fm + ((wgid % nig) % gsz); u.pn = (wgid % nig) / gsz; return true;
    }
    __device__ __forceinline__ const char* abase(const Gemm& g, const Unit& u) const { return (const char*)g.A + (size_t)u.pm * BM * g.lda * 2; }
    __device__ __forceinline__ const char* bbase(const Gemm& g, const Unit& u) const { return (const char*)g.Bt + (size_t)u.pn * BM * g.ldb * 2; }
    __device__ __forceinline__ unsigned arow(const Unit&, int) const { return 0u; }
};
template <bool GATHER_, int NPN_LOG2> struct MoeOrder {
    static constexpr bool GATHER = GATHER_;
    const PG8_LAS int* tab; const int* list; size_t bstride; int G, c;
    __device__ bool next(int i, Unit& u) const { const int L = i * G + c; if (L >= (tab[0] << NPN_LOG2)) return false; u.pm = L >> NPN_LOG2; u.pn = L & ((1 << NPN_LOG2) - 1); return true; }
    __device__ __forceinline__ const char* abase(const Gemm& g, const Unit& u) const { return GATHER_ ? (const char*)g.A : (const char*)g.A + (size_t)u.pm * BM * g.lda * 2; }
    __device__ __forceinline__ const char* bbase(const Gemm& g, const Unit& u) const { return (const char*)g.Bt + (size_t)tab[64 + u.pm] * bstride + (size_t)u.pn * BM * g.ldb * 2; }
    __device__ __forceinline__ unsigned arow(const Unit& u, int r) const { const int e = tab[64 + u.pm], idx = tab[224 + u.pm] + r; return idx < tab[1 + e] ? (unsigned)(list[(size_t)e * T + idx] >> 1) : 0u; }
};

typedef __bf16 bf16x2_t __attribute__((ext_vector_type(2)));
__device__ __forceinline__ unsigned cvt_pk_bf16(float lo, float hi) { const f32x2 v = {lo, hi}; const bf16x2_t b = __builtin_convertvector(v, bf16x2_t); return __builtin_bit_cast(unsigned, b); }
__device__ __forceinline__ f32x2 gelu_pk(f32x2 v) {
    const f32x2 av = __builtin_elementwise_abs(v), d = av * 0.2316418882f + 1.0f;
    f32x2 t; t.x = __builtin_amdgcn_rcpf(d.x); t.y = __builtin_amdgcn_rcpf(d.y);
    f32x2 q = t * 0.5307027145f + (-0.7265760135f); q = q * t + 0.7107068705f; q = q * t + (-0.142248368f); q = q * t + 0.127414796f; q = q * t;
    const f32x2 s = (v * v) * (-0.72134752044f);
    f32x2 e; e.x = __builtin_amdgcn_exp2f(s.x); e.y = __builtin_amdgcn_exp2f(s.y);
    const f32x2 m = v * (q * e), r = v - m;
    f32x2 o; o.x = v.x < 0.f ? m.x : r.x; o.y = v.y < 0.f ? m.y : r.y; return o;
}

typedef f32x4 Acc[2][2][4][2];

struct EpiQKV {
    static constexpr bool PERM = true;
    const float* bias; const float* rc; const float* rs; bf16_t* Q; bf16_t* Kb; bf16_t* Vb;
    __device__ __forceinline__ void operator()(const Acc& acc, const Unit& u, int wr, int wc, int fr, int fq) const {
        const int tile = u.pn; int scol; bf16_t* dst; int ld; float sc = 1.f;
        if (tile < 4) { scol = (tile * 4 + wc) * 64; dst = Q + scol; ld = 1024; sc = QSCALE; }
        else if (tile == 4) { scol = 1024 + wc * 64; dst = Kb + wc * 64; ld = 256; }
        else { scol = 1280 + wc * 64; dst = Vb + wc * 64; ld = 256; }
        f32x4 b1[2], b2[2];
#pragma unroll
        for (int n = 0; n < 2; ++n) { b1[n] = *(const f32x4*)(bias + scol + 8 * fq + 4 * n); b2[n] = *(const f32x4*)(bias + scol + 32 + 8 * fq + 4 * n); }
#pragma unroll
        for (int ai = 0; ai < 2; ++ai)
#pragma unroll
            for (int m = 0; m < 4; ++m) {
                const int row = u.pm * BM + ai * HALF + wr * 64 + m * 16 + fr;
                f32x4 o1[2], o2[2];
#pragma unroll
                for (int n = 0; n < 2; ++n) {
                    const f32x4 x1 = acc[ai][0][m][n] + b1[n], x2 = acc[ai][1][m][n] + b2[n];
                    if (tile < 5) { const f32x4 cs = *(const f32x4*)(rc + (size_t)row * 32 + 8 * fq + 4 * n), sn = *(const f32x4*)(rs + (size_t)row * 32 + 8 * fq + 4 * n);
                        o1[n] = (x1 * cs - x2 * sn) * sc; o2[n] = (x2 * cs + x1 * sn) * sc; }
                    else { o1[n] = x1; o2[n] = x2; }
                }
                u32x4 w1, w2;
                w1.x = cvt_pk_bf16(o1[0][0], o1[0][1]); w1.y = cvt_pk_bf16(o1[0][2], o1[0][3]); w1.z = cvt_pk_bf16(o1[1][0], o1[1][1]); w1.w = cvt_pk_bf16(o1[1][2], o1[1][3]);
                w2.x = cvt_pk_bf16(o2[0][0], o2[0][1]); w2.y = cvt_pk_bf16(o2[0][2], o2[0][3]); w2.z = cvt_pk_bf16(o2[1][0], o2[1][1]); w2.w = cvt_pk_bf16(o2[1][2], o2[1][3]);
                bf16_t* rp = dst + (size_t)row * ld + 8 * fq;
                *(u32x4*)rp = w1; *(u32x4*)(rp + 32) = w2;
            }
    }
};
struct EpiResid {
    static constexpr bool PERM = false;
    const float* x; const float* bias; const float* gt; float* z;
    __device__ __forceinline__ void operator()(const Acc& acc, const Unit& u, int wr, int wc, int fr, int fq) const {
        const int col0 = u.pn * BM + wc * 32 + 4 * fq; const int b = (u.pm * BM) >> 13;
        f32x4 bv[2][2], gv[2][2];
#pragma unroll
        for (int bj = 0; bj < 2; ++bj)
#pragma unroll
            for (int n = 0; n < 2; ++n) { bv[bj][n] = *(const f32x4*)(bias + col0 + bj * HALF + n * 16); gv[bj][n] = *(const f32x4*)(gt + b * 6144 + col0 + bj * HALF + n * 16) + 1.0f; }
#pragma unroll
        for (int ai = 0; ai < 2; ++ai)
#pragma unroll
            for (int m = 0; m < 4; ++m) { const size_t off = (size_t)(u.pm * BM + ai * HALF + wr * 64 + m * 16 + fr) * D + col0;
#pragma unroll
                for (int bj = 0; bj < 2; ++bj)
#pragma unroll
                    for (int n = 0; n < 2; ++n) { const f32x4 xv = *(const f32x4*)(x + off + bj * HALF + n * 16);
                        *(f32x4*)(z + off + bj * HALF + n * 16) = xv * ALPHA + gv[bj][n] * (acc[ai][bj][m][n] + bv[bj][n]); }
                if (m & 1) asm volatile("" ::: "memory"); }
    }
};
struct EpiGeluUV {
    static constexpr bool PERM = true;
    const float* bias; bf16_t* U; bf16_t* V2; float* vstat;
    __device__ __forceinline__ void operator()(const Acc& acc, const Unit& u, int wr, int wc, int fr, int fq) const {
        const bool isv = u.pn >= 8; bf16_t* base = isv ? V2 : U; const int colt = (isv ? u.pn - 8 : u.pn) * BM;
        const int col0 = colt + wc * 32 + 8 * fq, bcol0 = u.pn * BM + wc * 32 + 8 * fq;
        f32x4 bv[2][2];
#pragma unroll
        for (int bj = 0; bj < 2; ++bj)
#pragma unroll
            for (int n = 0; n < 2; ++n) bv[bj][n] = *(const f32x4*)(bias + bcol0 + bj * HALF + 4 * n);
#pragma unroll
        for (int ai = 0; ai < 2; ++ai)
#pragma unroll
            for (int m = 0; m < 4; ++m) { const int row = u.pm * BM + ai * HALF + wr * 64 + m * 16 + fr; bf16_t* rowp = base + (size_t)row * GW + col0; float s = 0.f, s2 = 0.f;
#pragma unroll
                for (int bj = 0; bj < 2; ++bj) { f32x4 v0 = acc[ai][bj][m][0] + bv[bj][0], v1 = acc[ai][bj][m][1] + bv[bj][1];
                    const f32x2 a = gelu_pk((f32x2){v0[0], v0[1]}), bb = gelu_pk((f32x2){v0[2], v0[3]}), c = gelu_pk((f32x2){v1[0], v1[1]}), d = gelu_pk((f32x2){v1[2], v1[3]});
                    s += (a.x + a.y) + (bb.x + bb.y) + (c.x + c.y) + (d.x + d.y);
                    s2 += (a.x * a.x + a.y * a.y) + (bb.x * bb.x + bb.y * bb.y) + (c.x * c.x + c.y * c.y) + (d.x * d.x + d.y * d.y);
                    u32x4 w; w.x = cvt_pk_bf16(a.x, a.y); w.y = cvt_pk_bf16(bb.x, bb.y); w.z = cvt_pk_bf16(c.x, c.y); w.w = cvt_pk_bf16(d.x, d.y);
                    *(u32x4*)(rowp + bj * HALF) = w; }
                if (isv) { s += __shfl_xor(s, 16); s += __shfl_xor(s, 32); s2 += __shfl_xor(s2, 16); s2 += __shfl_xor(s2, 32);
                    if (fq == 0) *(f32x2*)(vstat + ((size_t)row * 32 + (u.pn - 8) * 4 + wc) * 2) = (f32x2){s, s2}; } }
    }
};
struct EpiMoe1 {
    static constexpr bool PERM = true;
    const PG8_LAS int* tab; const float* wl; bf16_t* act;
    __device__ __forceinline__ void operator()(const Acc& acc, const Unit& u, int wr, int wc, int fr, int fq) const {
        const int e = tab[64 + u.pm], r0 = tab[224 + u.pm], n_e = tab[1 + e];
        const int col0 = u.pn * HALF + wc * 32 + 8 * fq;
#pragma unroll
        for (int ai = 0; ai < 2; ++ai)
#pragma unroll
            for (int m = 0; m < 4; ++m) { const int rl = ai * HALF + wr * 64 + m * 16 + fr; const int idx = r0 + rl;
                const float w = idx < n_e ? wl[(size_t)e * T + idx] : 0.f;
                f32x4 o[2];
#pragma unroll
                for (int n = 0; n < 2; ++n) { const f32x4 g = acc[ai][0][m][n], up = acc[ai][1][m][n];
#pragma unroll
                    for (int i = 0; i < 4; ++i) { const float sg = g[i] * __builtin_amdgcn_rcpf(1.f + __builtin_amdgcn_exp2f(-g[i] * LOG2E)); o[n][i] = idx < n_e ? sg * up[i] * w : 0.f; } }
                u32x4 wv; wv.x = cvt_pk_bf16(o[0][0], o[0][1]); wv.y = cvt_pk_bf16(o[0][2], o[0][3]); wv.z = cvt_pk_bf16(o[1][0], o[1][1]); wv.w = cvt_pk_bf16(o[1][2], o[1][3]);
                *(u32x4*)(act + (size_t)(u.pm * BM + rl) * EFF + col0) = wv; }
    }
};
struct EpiMoe2 {
    static constexpr bool PERM = true;
    const PG8_LAS int* tab; const int* list; bf16_t* y2;
    __device__ __forceinline__ void operator()(const Acc& acc, const Unit& u, int wr, int wc, int fr, int fq) const {
        const int e = tab[64 + u.pm], r0 = tab[224 + u.pm], n_e = tab[1 + e];
        const int col0 = u.pn * BM + wc * 32 + 8 * fq; const int* lp = list + (size_t)e * T + r0 + wr * 64 + fr;
#pragma unroll
        for (int ai = 0; ai < 2; ++ai) {
            int ts[4];
#pragma unroll
            for (int m = 0; m < 4; ++m) { const int idx = r0 + ai * HALF + wr * 64 + m * 16 + fr; ts[m] = idx < n_e ? lp[ai * HALF + m * 16] : -1; }
#pragma unroll
            for (int m = 0; m < 4; ++m) {
                if (ts[m] >= 0) { bf16_t* rowp = y2 + (size_t)ts[m] * D + col0;
#pragma unroll
                    for (int bj = 0; bj < 2; ++bj) { const f32x4 v0 = acc[ai][bj][m][0], v1 = acc[ai][bj][m][1];
                        u32x4 w; w.x = cvt_pk_bf16(v0[0], v0[1]); w.y = cvt_pk_bf16(v0[2], v0[3]); w.z = cvt_pk_bf16(v1[0], v1[1]); w.w = cvt_pk_bf16(v1[2], v1[3]);
                        *(u32x4*)(rowp + bj * HALF) = w; } }
                asm volatile("" ::: "memory"); }
        }
    }
};

template <class Epi, class Sched, bool ALIGN_EPI>
__device__ __forceinline__ void gemm_phase(PG8_LAS unsigned char* lds, const Gemm g, const Sched& S, const Epi& E) {
    const int tid = fresh_tid();
    const int wid = __builtin_amdgcn_readfirstlane(tid >> 6), lane = tid & 63, wr = wid >> 2, wc = wid & 3, fr = lane & 15, fq = lane >> 4;
    const int K = g.K, nt = K / BK;
    int RA[2], CA[2]; unsigned voffB[2][2], cvA[2][2], nvA[2][2];
#pragma unroll
    for (int i = 0; i < 2; ++i) { int R, C; stage_rc(tid * 16 + i * 8192, R, C); const int Rb = Epi::PERM ? ((R & ~31) + perm32(R & 31)) : R; RA[i] = R; CA[i] = C;
#pragma unroll
        for (int h = 0; h < 2; ++h) { voffB[h][i] = (unsigned)((Rb + h * HALF) * g.ldb + C) * 2u; cvA[h][i] = (unsigned)((R + h * HALF) * g.lda + C) * 2u; nvA[h][i] = cvA[h][i]; } }
    const size_t kstep = (size_t)(BK * 2);
    const unsigned ldsw = (unsigned)wid * 1024u;
    const int aoff = lds_byte(wr * 64 + fr, fq * 8), boff = lds_byte(wc * 32 + fr, fq * 8);
#define PG8_SA(b, h) (((b) * 2 + (h)) * HTB)
#define PG8_SB(b, h) ((4 + (b) * 2 + (h)) * HTB)
#define PG8_STAGE(bufoff, gbase, voff) do { _Pragma("unroll") for (int _i = 0; _i < 2; ++_i) \
        __builtin_amdgcn_global_load_lds((const unsigned*)((const char*)(gbase) + (voff)[_i]), (PG8_LAS unsigned*)(lds + (bufoff) + ldsw + _i * 8192), 16, 0, 0); } while (0)
#define PG8_LDA(dst, b, h) do { _Pragma("unroll") for (int m = 0; m < 4; ++m) _Pragma("unroll") for (int k = 0; k < 2; ++k) dst[m][k] = *(const PG8_LAS bf16x8*)(lds + PG8_SA(b, h) + aoff + m * 2048 + k * 1024); } while (0)
#define PG8_LDB(dst, b, h) do { _Pragma("unroll") for (int n = 0; n < 2; ++n) _Pragma("unroll") for (int k = 0; k < 2; ++k) dst[n][k] = *(const PG8_LAS bf16x8*)(lds + PG8_SB(b, h) + boff + n * 2048 + k * 1024); } while (0)
#define PG8_MMA(ai, bj, At, Bt) do { __builtin_amdgcn_s_setprio(1); _Pragma("unroll") for (int m = 0; m < 4; ++m) _Pragma("unroll") for (int n = 0; n < 2; ++n) _Pragma("unroll") for (int k = 0; k < 2; ++k) \
        acc[ai][bj][m][n] = __builtin_amdgcn_mfma_f32_16x16x32_bf16(Bt[n][k], At[m][k], acc[ai][bj][m][n], 0, 0, 0); __builtin_amdgcn_s_setprio(0); } while (0)
#define PG8_WAIT_V(n) asm volatile("s_waitcnt vmcnt(" #n ")" ::: "memory")
#define PG8_WAIT_L(n) asm volatile("s_waitcnt lgkmcnt(" #n ")" ::: "memory")
#define PG8_BAR __builtin_amdgcn_s_barrier()
#define PG8_SCHED __builtin_amdgcn_sched_barrier(0)
#define PG8_GATHER(dst, un) do { _Pragma("unroll") for (int _i = 0; _i < 2; ++_i) _Pragma("unroll") for (int _h = 0; _h < 2; ++_h) dst[_h][_i] = (S.arow(un, _h * HALF + RA[_i]) * (unsigned)g.lda + (unsigned)CA[_i]) * 2u; } while (0)
    Unit cur, nxt; int ui = 0;
    if (!S.next(0, cur)) return;
    Acc acc;
#pragma unroll
    for (int a = 0; a < 2; ++a)
#pragma unroll
        for (int b = 0; b < 2; ++b)
#pragma unroll
            for (int m = 0; m < 4; ++m)
#pragma unroll
                for (int n = 0; n < 2; ++n) acc[a][b][m][n] = (f32x4){0.f, 0.f, 0.f, 0.f};
    bf16x8 At[4][2], B0[2][2], B1[2][2];
    if constexpr (Sched::GATHER) { PG8_GATHER(cvA, cur); }
    const char* cA = S.abase(g, cur); const char* cB = S.bbase(g, cur);
    PG8_STAGE(PG8_SB(0, 0), cB, voffB[0]); PG8_STAGE(PG8_SB(0, 1), cB, voffB[1]); PG8_STAGE(PG8_SA(0, 0), cA, cvA[0]); PG8_STAGE(PG8_SA(0, 1), cA, cvA[1]);
    if (wr == 1) PG8_BAR;
    PG8_WAIT_V(2); PG8_BAR;
    PG8_STAGE(PG8_SB(1, 0), cB + kstep, voffB[0]); PG8_STAGE(PG8_SA(1, 0), cA + kstep, cvA[0]); PG8_STAGE(PG8_SB(1, 1), cB + kstep, voffB[1]);
    PG8_WAIT_V(6); PG8_BAR;
    for (;;) {
        const bool has_next = S.next(ui + 1, nxt);
        if constexpr (Sched::GATHER) { if (has_next) { PG8_GATHER(nvA, nxt); } else {
#pragma unroll
            for (int i = 0; i < 2; ++i) { nvA[0][i] = cvA[0][i]; nvA[1][i] = cvA[1][i]; } } }
        const char* nA = has_next ? S.abase(g, nxt) : cA; const char* nB = has_next ? S.bbase(g, nxt) : cB;
#pragma unroll 1
        for (int t = 0; t < nt; t += 2) {
            const bool last = (t == nt - 2);
            const char* a1 = cA + (size_t)(t + 1) * kstep;
            const char* a2 = last ? nA : cA + (size_t)(t + 2) * kstep; const char* b2 = last ? nB : cB + (size_t)(t + 2) * kstep;
            const char* a3 = a2 + kstep; const char* b3 = b2 + kstep;
            unsigned wA[2][2];
#pragma unroll
            for (int i = 0; i < 2; ++i) { wA[0][i] = (Sched::GATHER && last) ? nvA[0][i] : cvA[0][i]; wA[1][i] = (Sched::GATHER && last) ? nvA[1][i] : cvA[1][i]; }
            PG8_LDB(B0, 0, 0); PG8_LDB(B1, 0, 1); PG8_SCHED; PG8_LDA(At, 0, 0); PG8_STAGE(PG8_SA(1, 1), a1, cvA[1]);
            PG8_WAIT_V(8); PG8_WAIT_L(0); PG8_BAR; PG8_MMA(0, 0, At, B0); PG8_MMA(0, 1, At, B1); PG8_BAR; PG8_SCHED;
            PG8_LDA(At, 0, 1); PG8_STAGE(PG8_SB(0, 0), b2, voffB[0]); PG8_STAGE(PG8_SB(0, 1), b2, voffB[1]); PG8_STAGE(PG8_SA(0, 0), a2, wA[0]);
            PG8_WAIT_V(8); PG8_WAIT_L(0); PG8_BAR; PG8_MMA(1, 0, At, B0); PG8_MMA(1, 1, At, B1); PG8_BAR; PG8_SCHED;
            PG8_LDB(B0, 1, 0); PG8_LDB(B1, 1, 1); PG8_SCHED; PG8_LDA(At, 1, 0); PG8_STAGE(PG8_SA(0, 1), a2, wA[1]);
            PG8_WAIT_V(8); PG8_WAIT_L(0); PG8_BAR; PG8_MMA(0, 0, At, B0); PG8_MMA(0, 1, At, B1); PG8_BAR; PG8_SCHED;
            PG8_LDA(At, 1, 1); PG8_STAGE(PG8_SB(1, 0), b3, voffB[0]); PG8_STAGE(PG8_SB(1, 1), b3, voffB[1]); PG8_STAGE(PG8_SA(1, 0), a3, wA[0]);
            PG8_WAIT_V(8); PG8_WAIT_L(0); PG8_BAR; PG8_MMA(1, 0, At, B0); PG8_MMA(1, 1, At, B1); PG8_BAR; PG8_SCHED;
        }
        if constexpr (ALIGN_EPI) { if (wr == 0) PG8_BAR; }
        E(acc, cur, wr, wc, fr, fq);
        if (!has_next) break;
#pragma unroll
        for (int a = 0; a < 2; ++a)
#pragma unroll
            for (int b = 0; b < 2; ++b)
#pragma unroll
                for (int m = 0; m < 4; ++m)
#pragma unroll
                    for (int n = 0; n < 2; ++n) acc[a][b][m][n] = (f32x4){0.f, 0.f, 0.f, 0.f};
        cur = nxt; cA = nA; cB = nB; ++ui;
#pragma unroll
        for (int i = 0; i < 2; ++i) { cvA[0][i] = nvA[0][i]; cvA[1][i] = nvA[1][i]; }
        if constexpr (ALIGN_EPI) { if (wr == 1) PG8_BAR; }
    }
    PG8_WAIT_V(0);
    if constexpr (!ALIGN_EPI) { if (wr == 0) PG8_BAR; }
    PG8_BAR;
#undef PG8_SA
#undef PG8_SB
#undef PG8_STAGE
#undef PG8_LDA
#undef PG8_LDB
#undef PG8_MMA
#undef PG8_WAIT_V
#undef PG8_WAIT_L
#undef PG8_BAR
#undef PG8_SCHED
#undef PG8_GATHER
}
}


namespace attn {
typedef float f32x16 __attribute__((ext_vector_type(16)));
typedef short bf16x8 __attribute__((ext_vector_type(8)));
typedef short s16x4 __attribute__((ext_vector_type(4)));
constexpr int KSTR = 144, VSTR = 192;
constexpr int LDS_K = 0, LDS_V = 256 * KSTR, LDS_END = LDS_V + 256 * VSTR;
__device__ __forceinline__ int crow(int i, int h) { return (i & 3) + 8 * (i >> 2) + 4 * h; }
__device__ __forceinline__ s16x4 vtr(const PG8_LAS unsigned char* p) { return __builtin_bit_cast(s16x4, __builtin_amdgcn_ds_read_tr16_b64_v4i16((__attribute__((address_space(3))) s16x4*)p)); }

__device__ __forceinline__ void attn_phase(const Params& p, PG8_LAS unsigned char* lds, int bid, int G) {
    const int tid = fresh_tid(), wid = __builtin_amdgcn_readfirstlane(tid >> 6), lane = tid & 63, r = lane & 31, h = lane >> 5;
    const bf16_t* Q = (const bf16_t*)(p.ws + WS_RA + RA_Q); const bf16_t* Kb = (const bf16_t*)(p.ws + WS_RA + RA_K); const bf16_t* Vb = (const bf16_t*)(p.ws + WS_RA + RA_V);
    bf16_t* O = (bf16_t*)(p.ws + WS_RA + RA_O);
#pragma unroll 1
    for (int unit = bid; unit < 512; unit += G) {
        const int kvh = unit & 3, qblk = (unit >> 2) & 63, b = unit >> 8;
        const size_t row0 = (size_t)b * SEQ + (size_t)qblk * 128;
        __syncthreads();
#pragma unroll
        for (int i = 0; i < 4; ++i) { const int pc = i * 512 + tid, key = pc >> 3, c = pc & 7;
            u32x4 kv = (u32x4){0u, 0u, 0u, 0u}, vv = (u32x4){0u, 0u, 0u, 0u};
            if (qblk > 0 || key >= 128) { const size_t gr = row0 + key - 128; kv = *(const u32x4*)(Kb + gr * 256 + kvh * 64 + c * 8); vv = *(const u32x4*)(Vb + gr * 256 + kvh * 64 + c * 8); }
            *(PG8_LAS u32x4*)(lds + LDS_K + key * KSTR + c * 16) = kv; *(PG8_LAS u32x4*)(lds + LDS_V + key * VSTR + c * 16) = vv; }
        __syncthreads();
        const int hq = kvh * 4 + (wid >> 1), qhalf = wid & 1;
        const float sink = p.in[9][hq] * LOG2E;
#pragma unroll 1
        for (int qt = 0; qt < 2; ++qt) {
            const int q0 = qhalf * 64 + qt * 32, kt0 = q0 >> 5;
            bf16x8 qf[4]; const bf16_t* qp = Q + (row0 + q0 + r) * 1024 + hq * 64 + h * 8;
#pragma unroll
            for (int d0 = 0; d0 < 4; ++d0) qf[d0] = *(const bf16x8*)(qp + d0 * 16);
            f32x16 s[5];
#pragma unroll
            for (int t = 0; t < 5; ++t) {
#pragma unroll
                for (int i = 0; i < 16; ++i) s[t][i] = 0.f;
                const PG8_LAS unsigned char* kp = lds + LDS_K + (32 * (kt0 + t) + r) * KSTR + h * 16;
#pragma unroll
                for (int d0 = 0; d0 < 4; ++d0) { const bf16x8 kf = *(const PG8_LAS bf16x8*)(kp + d0 * 32); s[t] = __builtin_amdgcn_mfma_f32_32x32x16_bf16(kf, qf[d0], s[t], 0, 0, 0); }
            }
#pragma unroll
            for (int i = 0; i < 16; ++i) { const int kk = crow(i, h); s[0][i] = kk > r ? s[0][i] : -INFINITY; s[4][i] = kk <= r ? s[4][i] : -INFINITY; }
            if (qblk == 0) {
#pragma unroll
                for (int t = 0; t < 4; ++t) if (kt0 + t < 4) {
#pragma unroll
                    for (int i = 0; i < 16; ++i) s[t][i] = -INFINITY; }
            }
            float m = sink;
#pragma unroll
            for (int t = 0; t < 5; ++t)
#pragma unroll
                for (int i = 0; i < 16; ++i) m = fmaxf(m, s[t][i]);
            m = fmaxf(m, __shfl_xor(m, 32));
            float sum = 0.f;
#pragma unroll
            for (int t = 0; t < 5; ++t)
#pragma unroll
                for (int i = 0; i < 16; ++i) { s[t][i] = __builtin_amdgcn_exp2f(s[t][i] - m); sum += s[t][i]; }
            sum += __shfl_xor(sum, 32); sum += __builtin_amdgcn_exp2f(sink - m);
            const float rinv = 1.f / sum;
            f32x16 o[2];
#pragma unroll
            for (int i = 0; i < 16; ++i) { o[0][i] = 0.f; o[1][i] = 0.f; }
#pragma unroll
            for (int t = 0; t < 5; ++t)
#pragma unroll
                for (int ss = 0; ss < 2; ++ss) {
                    u32x4 pw; pw.x = pg8::cvt_pk_bf16(s[t][8 * ss] * rinv, s[t][8 * ss + 1] * rinv); pw.y = pg8::cvt_pk_bf16(s[t][8 * ss + 2] * rinv, s[t][8 * ss + 3] * rinv);
                    pw.z = pg8::cvt_pk_bf16(s[t][8 * ss + 4] * rinv, s[t][8 * ss + 5] * rinv); pw.w = pg8::cvt_pk_bf16(s[t][8 * ss + 6] * rinv, s[t][8 * ss + 7] * rinv);
                    const bf16x8 pa = __builtin_bit_cast(bf16x8, pw);
                    const PG8_LAS unsigned char* vp = lds + LDS_V + (32 * (kt0 + t) + 16 * ss + 4 * h + ((lane & 15) >> 2)) * VSTR + (16 * ((lane >> 4) & 1) + 4 * (lane & 3)) * 2;
#pragma unroll
                    for (int d0 = 0; d0 < 2; ++d0) { const s16x4 lo = vtr(vp + d0 * 64), hi = vtr(vp + d0 * 64 + 8 * VSTR);
                        const bf16x8 vb = (bf16x8){lo[0], lo[1], lo[2], lo[3], hi[0], hi[1], hi[2], hi[3]};
                        o[d0] = __builtin_amdgcn_mfma_f32_32x32x16_bf16(pa, vb, o[d0], 0, 0, 0); }
                }
            bf16_t* op = O + (row0 + q0) * 1024 + hq * 64 + r;
#pragma unroll
            for (int i = 0; i < 16; ++i) { const int q = crow(i, h); op[(size_t)q * 1024] = (bf16_t)(pg8::cvt_pk_bf16(o[0][i], 0.f) & 0xffffu); op[(size_t)q * 1024 + 32] = (bf16_t)(pg8::cvt_pk_bf16(o[1][i], 0.f) & 0xffffu); }
        }
    }
    __syncthreads();
}
}

namespace sgu {
typedef float f32x16 __attribute__((ext_vector_type(16)));
typedef short bf16x8 __attribute__((ext_vector_type(8)));
typedef short s16x4 __attribute__((ext_vector_type(4)));
constexpr int WSTR = 272, VSTR = 576;
constexpr int LDS_W = 0, LDS_VN = 128 * WSTR, LDS_ST = LDS_VN + 128 * VSTR, LDS_BS = LDS_ST + 128 * 8, LDS_END = LDS_BS + 512;
__device__ __forceinline__ void gate_phase(const Params& p, PG8_LAS unsigned char* lds, int bid, int G) {
    const int tid = fresh_tid(), wid = __builtin_amdgcn_readfirstlane(tid >> 6), lane = tid & 63, r = lane & 31, h = lane >> 5;
    const bf16_t* U = (const bf16_t*)(p.ws + WS_RA + RA_U); const bf16_t* V2 = (const bf16_t*)(p.ws + WS_RA + RA_V2); bf16_t* GT = (bf16_t*)(p.ws + WS_RA + RA_GATED);
    const bf16_t* Wsb = (const bf16_t*)(p.ws + WS_WS); const float* vstat = (const float*)(p.ws + WS_VSTAT);
    PG8_LAS float* st = (PG8_LAS float*)(lds + LDS_ST); PG8_LAS float* bs = (PG8_LAS float*)(lds + LDS_BS);
#pragma unroll 1
    for (int unit = bid; unit < 1024; unit += G) {
        const int g = unit & 7, chunk = unit >> 3; const size_t row0 = (size_t)chunk * 128;
        __syncthreads();
        { const int row = tid >> 2, qd = tid & 3; const float* ps = vstat + ((row0 + row) * 32 + qd * 8) * 2; float a = 0.f, a2 = 0.f;
#pragma unroll
            for (int i = 0; i < 4; ++i) { const f32x4 v = *(const f32x4*)(ps + 4 * i); a += v.x + v.z; a2 += v.y + v.w; }
            a += __shfl_xor(a, 1); a += __shfl_xor(a, 2); a2 += __shfl_xor(a2, 1); a2 += __shfl_xor(a2, 2);
            const float mean = a * (1.f / GW), var = fmaxf(a2 * (1.f / GW) - mean * mean, 0.f);
            if (qd == 0) { st[row * 2] = mean; st[row * 2 + 1] = 1.f / sqrtf(var + LN_EPS); }
            if (tid < 128) bs[tid] = p.in[17][g * 128 + tid]; }
#pragma unroll
        for (int i = 0; i < 4; ++i) { const int pc = i * 512 + tid, t = pc >> 4, c = pc & 15;
            *(PG8_LAS u32x4*)(lds + LDS_W + t * WSTR + c * 16) = *(const u32x4*)(Wsb + (size_t)(g * 128 + t) * 128 + c * 8); }
        __syncthreads();
        { const int c = tid & 31; const int col = g * 256 + c * 8;
            const f32x4 g0 = *(const f32x4*)(p.in[14] + col), g1 = *(const f32x4*)(p.in[14] + col + 4), b0 = *(const f32x4*)(p.in[15] + col), b1 = *(const f32x4*)(p.in[15] + col + 4);
#pragma unroll
            for (int i = 0; i < 8; ++i) { const int srow = i * 16 + (tid >> 5);
                const u32x4 v = *(const u32x4*)(V2 + (row0 + srow) * GW + col); const float mu = st[srow * 2], rs = st[srow * 2 + 1];
                f32x4 x0, x1; x0.x = __builtin_bit_cast(float, v.x << 16); x0.y = __builtin_bit_cast(float, v.x & 0xffff0000u); x0.z = __builtin_bit_cast(float, v.y << 16); x0.w = __builtin_bit_cast(float, v.y & 0xffff0000u);
                x1.x = __builtin_bit_cast(float, v.z << 16); x1.y = __builtin_bit_cast(float, v.z & 0xffff0000u); x1.z = __builtin_bit_cast(float, v.w << 16); x1.w = __builtin_bit_cast(float, v.w & 0xffff0000u);
                x0 = (x0 - mu) * rs * g0 + b0; x1 = (x1 - mu) * rs * g1 + b1;
                u32x4 w; w.x = pg8::cvt_pk_bf16(x0.x, x0.y); w.y = pg8::cvt_pk_bf16(x0.z, x0.w); w.z = pg8::cvt_pk_bf16(x1.x, x1.y); w.w = pg8::cvt_pk_bf16(x1.z, x1.w);
                *(PG8_LAS u32x4*)(lds + LDS_VN + srow * VSTR + c * 16) = w; } }
        __syncthreads();
        bf16x8 bf[8];
        { const PG8_LAS unsigned char* vp = lds + LDS_VN + (8 * h + ((lane & 15) >> 2)) * VSTR + (32 * wid + 16 * ((lane >> 4) & 1) + 4 * (lane & 3)) * 2;
#pragma unroll
            for (int ks = 0; ks < 8; ++ks) { const s16x4 lo = attn::vtr(vp + ks * 16 * VSTR), hi = attn::vtr(vp + ks * 16 * VSTR + 4 * VSTR);
                bf[ks] = (bf16x8){lo[0], lo[1], lo[2], lo[3], hi[0], hi[1], hi[2], hi[3]}; } }
#pragma unroll
        for (int tt = 0; tt < 4; ++tt) {
            f32x16 acc;
#pragma unroll
            for (int i = 0; i < 16; ++i) acc[i] = 0.f;
            const PG8_LAS unsigned char* wp = lds + LDS_W + (32 * tt + r) * WSTR + h * 16;
#pragma unroll
            for (int ks = 0; ks < 2 * tt + 2; ++ks) { const bf16x8 af = *(const PG8_LAS bf16x8*)(wp + ks * 32); acc = __builtin_amdgcn_mfma_f32_32x32x16_bf16(af, bf[ks], acc, 0, 0, 0); }
            const size_t obase = (row0 + 32 * tt) * GW + g * 256 + 32 * wid + r;
#pragma unroll
            for (int i = 0; i < 16; ++i) { const int t = attn::crow(i, h); const float mixed = acc[i] + bs[32 * tt + t];
                const float u = bf2f(U[obase + (size_t)t * GW]); GT[obase + (size_t)t * GW] = (bf16_t)(pg8::cvt_pk_bf16(u * mixed, 0.f) & 0xffffu); }
        }
    }
    __syncthreads();
}
}

#define XB_TMO      128
#define XB_XCNT(j)  (256  + 64 * (j))
#define XB_XSUB(j)  (1280 + 64 * (j))
#define XB_XGEN(j)  (2304 + 64 * (j))
#define XB_TOP      3328
#define XB_TOPGEN   3392
#define XCD_BAR_WORDS 3456
#define XB_SPIN_CAP (1u << 18)

__device__ __forceinline__ unsigned xb_ld(unsigned* p)              { return __hip_atomic_load(p, __ATOMIC_RELAXED, __HIP_MEMORY_SCOPE_AGENT); }
__device__ __forceinline__ unsigned xb_add(unsigned* p, unsigned v) { return __hip_atomic_fetch_add(p, v, __ATOMIC_RELAXED, __HIP_MEMORY_SCOPE_AGENT); }
__device__ __forceinline__ unsigned xb_xcc_id() { return (unsigned)__builtin_amdgcn_s_getreg((3 << 11) | 20) & 0xFu; }
#define XB_SPIN(cond, bar) do { unsigned _sp = 0; while (cond) { __builtin_amdgcn_s_sleep(1); \
    if ((++_sp & 255u) == 0u) { if (xb_ld(&(bar)[XB_TMO])) break; if (_sp > XB_SPIN_CAP) { atomicAdd(&(bar)[XB_TMO], 1u); break; } } } } while (0)

struct XcdBarrier {
    unsigned* bar; unsigned x;
    volatile PG8_LAS unsigned* st;
};

__device__ __forceinline__ XcdBarrier xcd_barrier_post(unsigned* bar, volatile PG8_LAS unsigned* st) {
    XcdBarrier b; b.bar = bar; b.x = xb_xcc_id(); b.st = st;
    if (threadIdx.x == 0) (void)xb_add(&bar[XB_XCNT(b.x)], 1u);
    return b;
}
__device__ __forceinline__ void xcd_barrier_complete(unsigned* bar, unsigned x, unsigned& nloc, unsigned& nx) {
    const unsigned G = gridDim.x * gridDim.y * gridDim.z;
    unsigned sum, cnt, mine, sp = 0u;
    for (;;) {
        sum = 0u; cnt = 0u; mine = 0u;
#pragma unroll
        for (unsigned j = 0; j < 16; ++j) { const unsigned c = xb_ld(&bar[XB_XCNT(j)]); sum += c; cnt += (c > 0u) ? 1u : 0u; mine = (j == x) ? c : mine; }
        if (sum == G) break;
        __builtin_amdgcn_s_sleep(1);
        if ((++sp & 255u) == 0u) { if (xb_ld(&bar[XB_TMO])) break; if (sp > XB_SPIN_CAP) { atomicAdd(&bar[XB_TMO], 1u); break; } }
    }
    nloc = mine > 0u ? mine : 1u; nx = cnt > 0u ? cnt : 1u;
}

__device__ __forceinline__ void xcd_barrier(const XcdBarrier& b) {
    asm volatile("s_waitcnt vmcnt(0)" ::: "memory");
    __syncthreads();
    if (threadIdx.x == 0) {
        unsigned* bar = b.bar;
        __builtin_amdgcn_s_waitcnt(0);
        unsigned nloc = b.st[0], nx = b.st[1];
        if (nloc == 0u) { xcd_barrier_complete(bar, b.x, nloc, nx); b.st[0] = nloc; b.st[1] = nx; }
        const unsigned old = xb_add(&bar[XB_XSUB(b.x)], 1u);
        const unsigned gen = old / nloc;
        if (old + 1u == (gen + 1u) * nloc) {
            __builtin_amdgcn_fence(__ATOMIC_RELEASE, "agent");
            asm volatile("s_waitcnt vmcnt(0)" ::: "memory");
            const unsigned og = xb_add(&bar[XB_TOP], 1u);
            const unsigned tg = og / nx;
            if (og + 1u == (tg + 1u) * nx) xb_add(&bar[XB_TOPGEN], 1u);
            else XB_SPIN(xb_ld(&bar[XB_TOPGEN]) == tg, bar);
            __builtin_amdgcn_fence(__ATOMIC_ACQUIRE, "agent");
            xb_add(&bar[XB_XGEN(b.x)], 1u);
            asm volatile("s_waitcnt vmcnt(0)" ::: "memory");
        } else {
            XB_SPIN(xb_ld(&bar[XB_XGEN(b.x)]) == gen, bar);
            __builtin_amdgcn_fence(__ATOMIC_ACQUIRE, "agent");
            asm volatile("s_waitcnt vmcnt(0)" ::: "memory");
        }
    }
    __syncthreads();
}

constexpr int LDS_BYTES = 152 * 1024, MISC_OFF = 147456;
struct MArgs { Params p; int lo, hi, li, pad; };
constexpr int NPHASE = 16;
#ifndef PROF_MASK
#define PROF_MASK 0u
#endif
#ifndef PROF_SYNC
#define PROF_SYNC 0
#endif

__device__ __forceinline__ void moe_build_tab(const Params& p, int l, PG8_LAS int* tab) {
    const int tid = fresh_tid();
    if (tid < 64) {
        const int n = tid < 32 ? ((const int*)(p.ws + WS_CTL))[l * 32 + tid] : 0; const int ntl = (n + 255) >> 8;
        int incl = ntl;
#pragma unroll
        for (int o = 1; o < 64; o <<= 1) { const int v = __shfl_up(incl, o); if (tid >= o) incl += v; }
        const int off = incl - ntl;
        if (tid < 32) { tab[1 + tid] = n; for (int j = 0; j < ntl; ++j) { tab[64 + off + j] = tid; tab[224 + off + j] = j * 256; } }
        if (tid == 31) tab[0] = incl;
    }
    __syncthreads();
}

__global__ void __launch_bounds__(512, 2) mega(MArgs a) {
    extern __shared__ __attribute__((aligned(16))) unsigned char lds_raw[];
    PG8_LAS unsigned char* lds = (PG8_LAS unsigned char*)lds_raw;
    PG8_LAS int* tab = (PG8_LAS int*)(lds + MISC_OFF);
    const Params& p = a.p; unsigned char* ws = p.ws;
    const int lo = a.lo, hi = a.hi, G = gridDim.x, bid = blockIdx.x;
    volatile PG8_LAS unsigned* bst = (volatile PG8_LAS unsigned*)(lds + MISC_OFF + 2048);
    if (threadIdx.x < 2) bst[threadIdx.x] = 0u;
    __syncthreads();
    XcdBarrier xbar = xcd_barrier_post((unsigned*)(ws + WS_CTL + 16384) + a.li * XCD_BAR_WORDS, bst);
    float* Z = p.out; float* X1 = (float*)(ws + WS_X1); float* X2 = (float*)(ws + WS_X2); const float* mod = (const float*)(ws + WS_MOD);
    bf16_t* H = (bf16_t*)(ws + WS_H);
#ifndef TESTPH
#define TESTPH -1
#endif
#define INC(c, k) ((TESTPH < 0 || TESTPH == (c)) && lo <= (k) && (k) < hi)
#define IN(k) INC(k, k)
#define REPS(k) (((PROF_MASK >> (k)) & 1u) ? 2 : 1)
#define SEAM(k) do { if (lo <= (k) && (k) + 1 < hi) { for (int _r = 0; _r <= PROF_SYNC; ++_r) xcd_barrier(xbar); } } while (0)
#define MOE_BLOCK(l, pb) { \
        const int* list = (const int*)(ws + WS_LIST) + (size_t)(l) * 32 * T; const float* wl = (const float*)(ws + WS_WL) + (size_t)(l) * 32 * T; \
        if (INC(5, (pb) + 5)) { for (int rep = 0; rep < REPS((pb) + 5); ++rep) { phase_ln_router(p, (l), Z, X1, bid, G, (float*)lds_raw, rep == 0); __syncthreads(); } } SEAM((pb) + 5); \
        if (INC(6, (pb) + 6)) for (int rep = 0; rep < REPS((pb) + 6); ++rep) { \
            moe_build_tab(p, (l), tab); \
            pg8::Gemm g{H, (const bf16_t*)(ws + WS_WGU) + (size_t)(l) * 32 * 512 * 1024, D, D, D}; \
            pg8::MoeOrder<true, 1> S{tab, list, (size_t)512 * 1024 * 2, G, bid}; \
            pg8::EpiMoe1 E{tab, wl, (bf16_t*)(ws + WS_RA + RA_ACT)}; \
            pg8::gemm_phase<pg8::EpiMoe1, pg8::MoeOrder<true, 1>, true>(lds, g, S, E); \
        } SEAM((pb) + 6); \
        if (INC(7, (pb) + 7)) for (int rep = 0; rep < REPS((pb) + 7); ++rep) { \
            moe_build_tab(p, (l), tab); \
            pg8::Gemm g{(const bf16_t*)(ws + WS_RA + RA_ACT), (const bf16_t*)(ws + WS_WD) + (size_t)(l) * 32 * 1024 * 256, EFF, EFF, EFF}; \
            pg8::MoeOrder<false, 2> S{tab, list, (size_t)1024 * 256 * 2, G, bid}; \
            pg8::EpiMoe2 E{tab, list, (bf16_t*)(ws + WS_RA + RA_Y2)}; \
            pg8::gemm_phase<pg8::EpiMoe2, pg8::MoeOrder<false, 2>, true>(lds, g, S, E); \
        } SEAM((pb) + 7); \
        if (INC(8, (pb) + 8)) { for (int rep = 0; rep < REPS((pb) + 8); ++rep) phase_ln2(p, (l), X1, (l) == 0 ? X2 : p.out, (l) == 0 ? 1 : -1, bid, G); } SEAM((pb) + 8); }
    if (IN(0)) { for (int rep = 0; rep < REPS(0); ++rep) { p0_prologue(p, bid, G, (float*)lds_raw); __syncthreads(); } } SEAM(0);
    if (IN(1)) { for (int rep = 0; rep < REPS(1); ++rep) phase_h0(p, bid, G); } SEAM(1);
    if (IN(2)) for (int rep = 0; rep < REPS(2); ++rep) {
        pg8::Gemm g{H, (const bf16_t*)(ws + WS_WQKV), D, D, D}; pg8::StaticOrder S; S.init(T, NQKV, G, bid);
        pg8::EpiQKV E{p.in[8], (const float*)(ws + WS_ROPE_C), (const float*)(ws + WS_ROPE_S), (bf16_t*)(ws + WS_RA + RA_Q), (bf16_t*)(ws + WS_RA + RA_K), (bf16_t*)(ws + WS_RA + RA_V)};
        pg8::gemm_phase<pg8::EpiQKV, pg8::StaticOrder, true>(lds, g, S, E);
    } SEAM(2);
    if (IN(3)) { for (int rep = 0; rep < REPS(3); ++rep) attn::attn_phase(p, lds, bid, G); } SEAM(3);
    if (IN(4)) for (int rep = 0; rep < REPS(4); ++rep) {
        pg8::Gemm g{(const bf16_t*)(ws + WS_RA + RA_O), (const bf16_t*)(ws + WS_WO), D, D, D}; pg8::StaticOrder S; S.init(T, D, G, bid);
        pg8::EpiResid E{p.in[0], p.in[11], mod + 2 * 1024, Z};
        pg8::gemm_phase<pg8::EpiResid, pg8::StaticOrder, true>(lds, g, S, E);
    } SEAM(4);
    MOE_BLOCK(0, 0)
    if (IN(9)) for (int rep = 0; rep < REPS(9); ++rep) {
        pg8::Gemm g{H, (const bf16_t*)(ws + WS_WIN), D, D, D}; pg8::StaticOrder S; S.init(T, 2 * GW, G, bid);
        pg8::EpiGeluUV E{p.in[13], (bf16_t*)(ws + WS_RA + RA_U), (bf16_t*)(ws + WS_RA + RA_V2), (float*)(ws + WS_VSTAT)};
        pg8::gemm_phase<pg8::EpiGeluUV, pg8::StaticOrder, true>(lds, g, S, E);
    } SEAM(9);
    if (IN(10)) { for (int rep = 0; rep < REPS(10); ++rep) sgu::gate_phase(p, lds, bid, G); } SEAM(10);
    if (IN(11)) for (int rep = 0; rep < REPS(11); ++rep) {
        pg8::Gemm g{(const bf16_t*)(ws + WS_RA + RA_GATED), (const bf16_t*)(ws + WS_WOUT), GW, GW, GW}; pg8::StaticOrder S; S.init(T, D, G, bid);
        pg8::EpiResid E{X2, p.in[19], mod + 2 * 6144 + 2 * 1024, Z};
        pg8::gemm_phase<pg8::EpiResid, pg8::StaticOrder, true>(lds, g, S, E);
    } SEAM(11);
    MOE_BLOCK(1, 7)
#undef IN
#undef SEAM
#undef MOE_BLOCK
}

static const bool FAST[NPHASE] = {1, 1, 1, 1, 1, 1, 1, 1, 1, 1, 1, 1, 1, 1, 1, 1};
static const bool CUT[NPHASE + 1] = {0, 0, 0, 0, 0, 0, 0, 0, 0, 0, 0, 0, 0, 0, 0, 0, 0};

extern "C" void kernel_launch(void* const* d_in, const int* in_sizes, int n_in, void* d_out, int out_size, void* d_ws, size_t ws_size, hipStream_t stream) {
    if (n_in != 26 || out_size != T * D || ws_size < WS_END) { fprintf(stderr, "kernel_launch: unexpected problem (n_in %d out %d ws %zu)\n", n_in, out_size, ws_size); return; }
    static int grid = 0;
    if (!grid) {
        (void)hipFuncSetAttribute((const void*)k_ln_router, hipFuncAttributeMaxDynamicSharedMemorySize, 36 * 1024 * 4);
        (void)hipFuncSetAttribute((const void*)mega, hipFuncAttributeMaxDynamicSharedMemorySize, LDS_BYTES);
        int dev = 0, cus = 0, per_cu = 0;
        (void)hipGetDevice(&dev); (void)hipDeviceGetAttribute(&cus, hipDeviceAttributeMultiprocessorCount, dev);
        (void)hipOccupancyMaxActiveBlocksPerMultiprocessor(&per_cu, (const void*)mega, 512, LDS_BYTES);
        if (per_cu < 1) { fprintf(stderr, "kernel_launch: occupancy query says %d blocks per CU\n", per_cu); per_cu = 1; }
        grid = cus;
        fprintf(stderr, "kernel_launch: cus %d per_cu %d grid %d\n", cus, per_cu, grid);
    }
    Params p{};
    for (int i = 0; i < 26; ++i) p.in[i] = (const float*)d_in[i];
    p.out = (float*)d_out; p.ws = (unsigned char*)d_ws;
    unsigned char* ws = p.ws;
    float* Z = p.out; float* X1 = (float*)(ws + WS_X1); float* X2 = (float*)(ws + WS_X2); const float* mod = (const float*)(ws + WS_MOD);
    bf16_t* H = (bf16_t*)(ws + WS_H);
    const int* rowmap = (const int*)(ws + WS_TAB); const int* te = (const int*)(ws + WS_TAB) + 2 * MPAD;
    (void)hipMemsetAsync(ws + WS_CTL, 0, 64 * 1024, stream);
    int k = 0, nlaunch = 0;
    while (k < NPHASE) {
        if (FAST[k]) {
            int e = k + 1; while (e < NPHASE && FAST[e] && !CUT[e]) ++e;
            MArgs ma{p, k, e, nlaunch++, 0};
            hipLaunchKernelGGL(mega, dim3(grid), dim3(512), LDS_BYTES, stream, ma);
            k = e; continue;
        }
        const int l = k >= 9 ? 1 : 0; const int ph = (k >= 12) ? k - 7 : k;
        const int* nt = (const int*)(ws + WS_CTL) + 64 + l;
        switch (ph) {
        case 0: hipLaunchKernelGGL(k_prologue, dim3(256), dim3(512), 0, stream, p); break;
        case 1: hipLaunchKernelGGL(k_h0, dim3(256), dim3(512), 0, stream, p); break;
        case 2: { NG g{H, nullptr, (const bf16_t*)(ws + WS_WQKV), nullptr, nullptr, 0, D, D, D, 0};
            hipLaunchKernelGGL(ngemm<NEpiF32>, dim3(NQKV / 64, T / 64), dim3(256), 0, stream, g, NEpiF32{(float*)(ws + WS_RA + RA_QKVRAW), NQKV, 0});
            hipLaunchKernelGGL(k_rope_post, dim3(T * 768 / 256), dim3(256), 0, stream, p); } break;
        case 3: hipLaunchKernelGGL(k_attn_naive, dim3(T * 16 / 4), dim3(256), 0, stream, p); break;
        case 4: { NG g2{(const bf16_t*)(ws + WS_RA + RA_O), nullptr, (const bf16_t*)(ws + WS_WO), nullptr, nullptr, 0, D, D, D, 0};
            hipLaunchKernelGGL(ngemm<NEpiResid>, dim3(D / 64, T / 64), dim3(256), 0, stream, g2, NEpiResid{p.in[0], p.in[11], mod + 2 * 1024, Z}); } break;
        case 5: hipLaunchKernelGGL(k_ln_router, dim3(256), dim3(512), 36 * 1024 * 4, stream, KA{p, (const float*)Z, X1, l, 0}); break;
        case 6: { hipLaunchKernelGGL(k_moe_prep, dim3(1), dim3(256), 0, stream, KA{p, nullptr, nullptr, l, 0});
            NG g3{H, rowmap, (const bf16_t*)(ws + WS_WGU) + (size_t)l * 32 * 512 * 1024, te, nt, (size_t)512 * 1024, D, D, D, 0};
            hipLaunchKernelGGL(ngemm<NEpiF32>, dim3(512 / 64, MPAD / 64), dim3(256), 0, stream, g3, NEpiF32{(float*)(ws + WS_RA + RA_GURAW), 512, 0});
            hipLaunchKernelGGL(k_moe1_post, dim3(MPAD), dim3(256), 0, stream, KA{p, nullptr, nullptr, l, 0}); } break;
        case 7: { hipLaunchKernelGGL(k_moe_prep, dim3(1), dim3(256), 0, stream, KA{p, nullptr, nullptr, l, 0});
            NG g4{(const bf16_t*)(ws + WS_RA + RA_ACT), nullptr, (const bf16_t*)(ws + WS_WD) + (size_t)l * 32 * 1024 * 256, te, nt, (size_t)1024 * 256, EFF, EFF, EFF, 0};
            hipLaunchKernelGGL(ngemm<NEpiMoe2>, dim3(D / 64, MPAD / 64), dim3(256), 0, stream, g4, NEpiMoe2{rowmap, (bf16_t*)(ws + WS_RA + RA_Y2)}); } break;
        case 8: hipLaunchKernelGGL(k_ln2, dim3(256), dim3(512), 0, stream, KA{p, (const float*)X1, l == 0 ? X2 : p.out, l, l == 0 ? 1 : -1}); break;
        case 9: { NG g{H, nullptr, (const bf16_t*)(ws + WS_WIN), nullptr, nullptr, 0, D, D, D, 0};
            hipLaunchKernelGGL(ngemm<NEpiGelu>, dim3(4096 / 64, T / 64), dim3(256), 0, stream, g, NEpiGelu{p.in[13], (bf16_t*)(ws + WS_RA + RA_U), (bf16_t*)(ws + WS_RA + RA_V2)});
            hipLaunchKernelGGL(k_vstat_naive, dim3(T / 4), dim3(256), 0, stream, p); } break;
        case 10: { if (FAST[9]) hipLaunchKernelGGL(k_vstat_bridge, dim3(T / 256), dim3(256), 0, stream, p);
            hipLaunchKernelGGL(k_gate_naive, dim3(T * GW / 256), dim3(256), 0, stream, p); } break;
        case 11: { NG g2{(const bf16_t*)(ws + WS_RA + RA_GATED), nullptr, (const bf16_t*)(ws + WS_WOUT), nullptr, nullptr, 0, GW, GW, GW, 0};
            hipLaunchKernelGGL(ngemm<NEpiResid>, dim3(D / 64, T / 64), dim3(256), 0, stream, g2, NEpiResid{X2, p.in[19], mod + 2 * 6144 + 2 * 1024, Z}); } break;
        }
        ++k;
    }
}
```

```cpp
#include <hip/hip_runtime.h>
#include <cstdio>
#include <cstdint>

typedef unsigned short bf16_t;
typedef unsigned u32x4 __attribute__((ext_vector_type(4)));
typedef unsigned u32x2 __attribute__((ext_vector_type(2)));
typedef float f32x4 __attribute__((ext_vector_type(4)));
typedef float f32x2v __attribute__((ext_vector_type(2)));

constexpr int T = 16384, D = 1024, SEQ = 8192;
constexpr int NQKV = 1536, GW = 2048  , NEXP = 32, EFF = 256;
constexpr float LN_EPS = 1e-5f, ALPHA = 1.4142135623730951f;
constexpr float QSCALE = 0.125f * 1.4426950408889634f;
constexpr float LOG2E = 1.4426950408889634f;
constexpr int MAXTILES = 160, MPAD = MAXTILES * 256;

constexpr size_t MiB = 1u << 20;
constexpr size_t WS_CTL = 0;
constexpr size_t WS_MOD = 64 * 1024;
constexpr size_t WS_ROPE_C = 1 * MiB, WS_ROPE_S = 3 * MiB;
constexpr size_t WS_WS = 5 * MiB;
constexpr size_t WS_VSTAT = 6 * MiB;
constexpr size_t WS_LIST = 10 * MiB;
constexpr size_t WS_WL = 14 * MiB;
constexpr size_t WS_TAB = 18 * MiB;
constexpr size_t WS_ROWSTAT = 19 * MiB;
constexpr size_t WS_WQKV = 20 * MiB, WS_WO = 23 * MiB, WS_WIN = 25 * MiB, WS_WOUT = 33 * MiB, WS_WGU = 37 * MiB, WS_WD = 101 * MiB;
constexpr size_t WS_H = 133 * MiB, WS_X1 = 165 * MiB, WS_X2 = 229 * MiB, WS_RA = 293 * MiB, WS_END = 485 * MiB;
constexpr size_t RA_Q = 0, RA_K = 32 * MiB, RA_V = 40 * MiB, RA_O = 48 * MiB, RA_QKVRAW = 80 * MiB;
constexpr size_t RA_U = 0, RA_V2 = 64 * MiB, RA_GATED = 128 * MiB;
constexpr size_t RA_Y2 = 0, RA_ACT = 64 * MiB, RA_GURAW = 84 * MiB;

struct Params {
    const float* in[26];
    float* out;
    unsigned char* ws;
};
struct KA { Params p; const float* a; float* b; int i0, i1; };

__device__ __forceinline__ unsigned f2bf(float f) { unsigned u = __builtin_bit_cast(unsigned, f); return (u + 0x7fffu + ((u >> 16) & 1u)) >> 16; }
__device__ __forceinline__ unsigned pk2(float lo, float hi) { return f2bf(lo) | (f2bf(hi) << 16); }
typedef __bf16 bf16x2c_t __attribute__((ext_vector_type(2)));
__device__ __forceinline__ unsigned pg8c(float lo, float hi) { const f32x2v v = {lo, hi}; const bf16x2c_t b = __builtin_convertvector(v, bf16x2c_t); return __builtin_bit_cast(unsigned, b); }
__device__ __forceinline__ float bf2f(bf16_t v) { return __builtin_bit_cast(float, (unsigned)v << 16); }
__device__ __forceinline__ float wave_sum(float v) {
#pragma unroll
    for (int o = 1; o < 64; o <<= 1) v += __shfl_xor(v, o);
    return v;
}
__device__ __forceinline__ float wave_max(float v) {
#pragma unroll
    for (int o = 1; o < 64; o <<= 1) v = fmaxf(v, __shfl_xor(v, o));
    return v;
}
__device__ __forceinline__ void unpack8(const u32x4 v, float* f) {
    f[0] = __builtin_bit_cast(float, v.x << 16); f[1] = __builtin_bit_cast(float, v.x & 0xffff0000u); f[2] = __builtin_bit_cast(float, v.y << 16); f[3] = __builtin_bit_cast(float, v.y & 0xffff0000u);
    f[4] = __builtin_bit_cast(float, v.z << 16); f[5] = __builtin_bit_cast(float, v.z & 0xffff0000u); f[6] = __builtin_bit_cast(float, v.w << 16); f[7] = __builtin_bit_cast(float, v.w & 0xffff0000u);
}
__device__ __forceinline__ float row16_sum(float v) {
    v += __builtin_bit_cast(float, __builtin_amdgcn_mov_dpp(__builtin_bit_cast(int, v), 0xB1, 0xF, 0xF, true));
    v += __builtin_bit_cast(float, __builtin_amdgcn_mov_dpp(__builtin_bit_cast(int, v), 0x4E, 0xF, 0xF, true));
    v += __builtin_bit_cast(float, __builtin_amdgcn_mov_dpp(__builtin_bit_cast(int, v), 0x141, 0xF, 0xF, true));
    v += __builtin_bit_cast(float, __builtin_amdgcn_mov_dpp(__builtin_bit_cast(int, v), 0x140, 0xF, 0xF, true));
    return v;
}
__device__ __forceinline__ float silu_f(float v) { return v / (1.f + expf(-v)); }

__device__ __forceinline__ int slot_qkv(int n) {
    int tile, hl, d;
    if (n < 1024) { const int head = n >> 6; d = n & 63; tile = head >> 2; hl = head & 3; }
    else if (n < 1280) { const int m = n - 1024; tile = 4; hl = m >> 6; d = m & 63; }
    else { const int m = n - 1280; tile = 5; hl = m >> 6; d = m & 63; }
    return tile * 256 + (d >> 5) * 128 + hl * 32 + (d & 31);
}
__device__ __forceinline__ int slot_gu(int n) {
    const int up = n >> 8, c = n & 255, pn = c >> 7; return pn * 256 + up * 128 + (c & 127);
}

__device__ __forceinline__ int fresh_tid() { int t = threadIdx.x; asm volatile("" : "+v"(t)); return t; }

__device__ __forceinline__ void mods_item(int tid, int item, const float* c, const float* ada_w, const float* ada_b, float* mod, float* lds) {
    const int wave = tid >> 6, lane = tid & 63;
    const int l = item / 96, cg = item % 96;
    const float* W = ada_w + (size_t)l * 1024 * 6144 + cg * 64 + lane;
    float a0 = 0.f, a1 = 0.f;
    const int kb = wave * 128;
#pragma unroll 8
    for (int k = 0; k < 128; ++k) {
        const float w = W[(size_t)(kb + k) * 6144];
        a0 += silu_f(c[kb + k]) * w; a1 += silu_f(c[1024 + kb + k]) * w;
    }
    lds[(wave * 2 + 0) * 64 + lane] = a0; lds[(wave * 2 + 1) * 64 + lane] = a1;
    __syncthreads();
    if (tid < 128) { const int b = tid >> 6; float s = 0.f;
#pragma unroll
        for (int w = 0; w < 8; ++w) s += lds[(w * 2 + b) * 64 + lane];
        mod[(size_t)(l * 2 + b) * 6144 + cg * 64 + lane] = s + ada_b[l * 6144 + cg * 64 + lane]; }
    __syncthreads();
}
__device__ __forceinline__ void conv_item(const float* src, int K, int N, bf16_t* dst, int map, int item, int lane) {
    const int nblk = N >> 6, kb = item / nblk, nb = item % nblk, k0 = kb * 32, n = nb * 64 + lane;
    const float* s = src + (size_t)k0 * N + n;
    float v[32];
#pragma unroll
    for (int t = 0; t < 32; ++t) v[t] = s[(size_t)t * N];
    const int slot = map == 1 ? slot_qkv(n) : (map == 2 ? slot_gu(n) : n);
    u32x4* d = (u32x4*)(dst + (size_t)slot * K + k0);
#pragma unroll
    for (int j = 0; j < 4; ++j) { u32x4 o; o.x = pk2(v[8 * j], v[8 * j + 1]); o.y = pk2(v[8 * j + 2], v[8 * j + 3]); o.z = pk2(v[8 * j + 4], v[8 * j + 5]); o.w = pk2(v[8 * j + 6], v[8 * j + 7]); d[j] = o; }
}
constexpr int CI_QKV = 32 * 24, CI_WO = 32 * 16, CI_WIN = 32 * 64, CI_WOUT = 64 * 16, CI_GU1 = 32 * 8, CI_GU = 64 * CI_GU1, CI_DN1 = 8 * 16, CI_DN = 64 * CI_DN1;
constexpr int CI_TOTAL = CI_QKV + CI_WO + CI_WIN + CI_WOUT + CI_GU + CI_DN;

__device__ __forceinline__ void p0_prologue(const Params& p, int wg, int nwg, float* lds) {
    const int tid = fresh_tid(), wave = tid >> 6, lane = tid & 63;
    unsigned char* ws = p.ws;
    for (int it = wg; it < 192; it += nwg) mods_item(tid, it, p.in[1], p.in[3], p.in[4], (float*)(ws + WS_MOD), lds);
    const int gw = wg * 8 + wave, ngw = nwg * 8;
    for (int it = gw; it < CI_TOTAL; it += ngw) {
        int r = it;
        if (r < CI_QKV) { conv_item(p.in[7], 1024, 1536, (bf16_t*)(ws + WS_WQKV), 1, r, lane); continue; } r -= CI_QKV;
        if (r < CI_WO) { conv_item(p.in[10], 1024, 1024, (bf16_t*)(ws + WS_WO), 0, r, lane); continue; } r -= CI_WO;
        if (r < CI_WIN) { conv_item(p.in[12], 1024, 4096, (bf16_t*)(ws + WS_WIN), 0, r, lane); continue; } r -= CI_WIN;
        if (r < CI_WOUT) { conv_item(p.in[18], 2048, 1024, (bf16_t*)(ws + WS_WOUT), 0, r, lane); continue; } r -= CI_WOUT;
        if (r < CI_GU) { const int mtx = r / CI_GU1; conv_item(p.in[24] + (size_t)mtx * 1024 * 512, 1024, 512, (bf16_t*)(ws + WS_WGU) + (size_t)mtx * 512 * 1024, 2, r % CI_GU1, lane); continue; } r -= CI_GU;
        { const int mtx = r / CI_DN1; conv_item(p.in[25] + (size_t)mtx * 256 * 1024, 256, 1024, (bf16_t*)(ws + WS_WD) + (size_t)mtx * 1024 * 256, 0, r % CI_DN1, lane); }
    }
    const int gt = wg * 512 + tid, ngt = nwg * 512;
    for (int i = gt; i < 8 * 128 * 128; i += ngt) { const int t = (i >> 7) & 127, s = i & 127; ((bf16_t*)(ws + WS_WS))[i] = (bf16_t)f2bf(s <= t ? p.in[16][i] : 0.f); }
    const int* pos = (const int*)p.in[2];
    for (int i = gt; i < T * 32; i += ngt) {
        const int row = i >> 5, j = i & 31;
        double f = 1.0;
        for (int q = 0; q < j; ++q) f *= 0.7498942093324558;
        const double rev = (double)pos[row] * f * 0.15915494309189535;
        const float fr = (float)(rev - floor(rev));
        ((float*)(ws + WS_ROPE_C))[i] = __builtin_amdgcn_cosf(fr);
        ((float*)(ws + WS_ROPE_S))[i] = __builtin_amdgcn_sinf(fr);
    }
}

__device__ __forceinline__ void phase_h0(const Params& p, int wg, int nwg) {
    const int tid = fresh_tid(), lane = tid & 63, gw = wg * 8 + (tid >> 6), ngw = nwg * 8;
    const float* x = p.in[0]; const float* mod = (const float*)(p.ws + WS_MOD); bf16_t* H = (bf16_t*)(p.ws + WS_H);
    for (int row = gw; row < T; row += ngw) {
        const int b = row >> 13; const float* sh = mod + (size_t)(0 * 2 + b) * 6144; const float* sc = sh + 1024;
#pragma unroll
        for (int j = 0; j < 4; ++j) { const int col = 4 * lane + 256 * j;
            const f32x4 xv = *(const f32x4*)(x + (size_t)row * D + col), s = *(const f32x4*)(sc + col), h = *(const f32x4*)(sh + col);
            const f32x4 o = xv * (s + 1.0f) + h; u32x2 w; w.x = pk2(o.x, o.y); w.y = pk2(o.z, o.w); *(u32x2*)(H + (size_t)row * D + col) = w; }
    }
}
__device__ __forceinline__ void phase_ln_router(const Params& p, int l, const bf16_t* z, bf16_t* xo, int wg, int nwg, float* lds, bool append = true) {
    const int tid = fresh_tid(), wave = tid >> 6, lane = tid & 63, rg = lane >> 4, j = lane & 15;
    const float* wgr = p.in[20] + (size_t)l * 1024 * 4; const float* bgr = p.in[21] + l * 4;
    const float* wer = p.in[22] + (size_t)l * 1024 * 32; const float* ber = p.in[23] + l * 32;
#pragma unroll 1
    for (int o = 0; o < 36; ++o)
        for (int k = tid; k < 1024; k += 512) lds[o * 1024 + k] = o < 4 ? wgr[k * 4 + o] : wer[k * 32 + (o - 4)];
    __syncthreads();
    const float* lg = p.in[5] + (size_t)(l * 2 + 0) * D; const float* lb = p.in[6] + (size_t)(l * 2 + 0) * D;
    const float* mod = (const float*)(p.ws + WS_MOD); bf16_t* H = (bf16_t*)(p.ws + WS_H);
    int* cnt = (int*)(p.ws + WS_CTL) + l * 32; int* list = (int*)(p.ws + WS_LIST) + (size_t)l * 32 * T; float* wl = (float*)(p.ws + WS_WL) + (size_t)l * 32 * T;
    const int gw = wg * 8 + wave, ngw = nwg * 8;
#pragma unroll 1
    for (int r4 = gw * 4; r4 < T; r4 += ngw * 4) {
        const int row = r4 + rg, b = row >> 13; const unsigned ro = (unsigned)row * D + 8u * j, mo = (unsigned)(l * 2 + b) * 6144u + 3u * 1024u + 8u * j;
        float v[8][8]; float s = 0.f;
#pragma unroll
        for (int i = 0; i < 8; ++i) { unpack8(*(const u32x4*)(z + (ro + 128u * i)), v[i]);
#pragma unroll
            for (int e = 0; e < 8; ++e) s += v[i][e]; }
        const float mean = row16_sum(s) * (1.f / D); float s2 = 0.f;
#pragma unroll
        for (int i = 0; i < 8; ++i)
#pragma unroll
            for (int e = 0; e < 8; ++e) { v[i][e] -= mean; s2 += v[i][e] * v[i][e]; }
        const float rstd = 1.f / sqrtf(row16_sum(s2) * (1.f / D) + LN_EPS);
#pragma unroll
        for (int i = 0; i < 8; ++i) { const unsigned col = 8u * j + 128u * i; u32x4 wx, wh;
#pragma unroll
            for (int q = 0; q < 2; ++q) { const f32x4 g4 = *(const f32x4*)(lg + (col + 4u * q)), b4 = *(const f32x4*)(lb + (col + 4u * q)), s4 = *(const f32x4*)(mod + (mo + 1024u + 128u * i + 4u * q)), h4 = *(const f32x4*)(mod + (mo + 128u * i + 4u * q));
                float x1[4];
#pragma unroll
                for (int e = 0; e < 4; ++e) { x1[e] = v[i][4 * q + e] * rstd * g4[e] + b4[e]; v[i][4 * q + e] = x1[e] * (s4[e] + 1.0f) + h4[e]; }
                const unsigned xa = pg8c(x1[0], x1[1]), xb = pg8c(x1[2], x1[3]), ha = pg8c(v[i][4 * q], v[i][4 * q + 1]), hb = pg8c(v[i][4 * q + 2], v[i][4 * q + 3]);
                if (q == 0) { wx.x = xa; wx.y = xb; wh.x = ha; wh.y = hb; } else { wx.z = xa; wx.w = xb; wh.z = ha; wh.w = hb; } }
            *(u32x4*)(xo + (ro + 128u * i)) = wx; *(u32x4*)(H + (ro + 128u * i)) = wh;
            asm volatile("" ::: "memory"); }
        float gl[4];
#pragma unroll
        for (int o = 0; o < 4; ++o) { float a = 0.f;
#pragma unroll
            for (int i = 0; i < 8; ++i) { const f32x4 w0 = *(const f32x4*)(lds + o * 1024 + 8 * j + 128 * i), w1 = *(const f32x4*)(lds + o * 1024 + 8 * j + 128 * i + 4);
                a += (v[i][0] * w0.x + v[i][1] * w0.y) + (v[i][2] * w0.z + v[i][3] * w0.w) + (v[i][4] * w1.x + v[i][5] * w1.y) + (v[i][6] * w1.z + v[i][7] * w1.w); }
            gl[o] = row16_sum(a) + bgr[o]; asm volatile("" ::: "memory"); }
        int g = 0; float gm = gl[0];
#pragma unroll
        for (int o = 1; o < 4; ++o) if (gl[o] > gm) { gm = gl[o]; g = o; }
        float gs = 0.f;
#pragma unroll
        for (int o = 0; o < 4; ++o) gs += expf(gl[o] - gm);
        const float gp = 1.f / gs;
        float v0 = -INFINITY, v1 = -INFINITY; int e0 = 0, e1 = 0;
#pragma unroll 1
        for (int e = 0; e < 8; ++e) { float a = 0.f; const float* wrow = lds + (4 + g * 8 + e) * 1024 + 8 * j;
#pragma unroll
            for (int i = 0; i < 8; ++i) { const f32x4 w0 = *(const f32x4*)(wrow + 128 * i), w1 = *(const f32x4*)(wrow + 128 * i + 4);
                a += (v[i][0] * w0.x + v[i][1] * w0.y) + (v[i][2] * w0.z + v[i][3] * w0.w) + (v[i][4] * w1.x + v[i][5] * w1.y) + (v[i][6] * w1.z + v[i][7] * w1.w); }
            const float val = row16_sum(a) + ber[g * 8 + e];
            if (val > v0) { v1 = v0; e1 = e0; v0 = val; e0 = e; } else if (val > v1) { v1 = val; e1 = e; }
            asm volatile("" ::: "memory"); }
        const float w0 = 1.f / (1.f + expf(v1 - v0)), w1 = 1.f - w0;
        if (j == 0 && append) {
            const int ea = g * 8 + e0, eb = g * 8 + e1;
            const int pa = atomicAdd(cnt + ea, 1); list[(size_t)ea * T + pa] = row * 2 + 0; wl[(size_t)ea * T + pa] = w0 * gp;
            const int pb = atomicAdd(cnt + eb, 1); list[(size_t)eb * T + pb] = row * 2 + 1; wl[(size_t)eb * T + pb] = w1 * gp;
        }
    }
}
__device__ __forceinline__ void phase_ln2(const Params& p, int l, const bf16_t* x1, bf16_t* xo, float* fo, int wg, int nwg) {
    const int tid = fresh_tid(), lane = tid & 63, gw = wg * 8 + (tid >> 6), ngw = nwg * 8;
    const float* lg = p.in[5] + (size_t)(l * 2 + 1) * D; const float* lb = p.in[6] + (size_t)(l * 2 + 1) * D;
    const float* mod = (const float*)(p.ws + WS_MOD); bf16_t* H = (bf16_t*)(p.ws + WS_H); const bf16_t* y2 = (const bf16_t*)(p.ws + WS_RA + RA_Y2);
#pragma unroll 1
    for (int row = gw; row < T; row += ngw) {
        const int b = row >> 13; const float* gt = mod + (size_t)(l * 2 + b) * 6144 + 5 * 1024;
        float v[2][8]; float s = 0.f;
#pragma unroll
        for (int i = 0; i < 2; ++i) { const int col = 8 * lane + 512 * i; float xv[8], ya[8], yb[8];
            unpack8(*(const u32x4*)(x1 + (size_t)row * D + col), xv); unpack8(*(const u32x4*)(y2 + ((size_t)row * 2 + 0) * D + col), ya); unpack8(*(const u32x4*)(y2 + ((size_t)row * 2 + 1) * D + col), yb);
            const f32x4 g0 = *(const f32x4*)(gt + col), g1 = *(const f32x4*)(gt + col + 4);
#pragma unroll
            for (int e = 0; e < 8; ++e) { v[i][e] = xv[e] * ALPHA + ((e < 4 ? g0[e & 3] : g1[e & 3]) + 1.0f) * (ya[e] + yb[e]); s += v[i][e]; } }
        const float mean = wave_sum(s) * (1.f / D); float s2 = 0.f;
#pragma unroll
        for (int i = 0; i < 2; ++i)
#pragma unroll
            for (int e = 0; e < 8; ++e) { v[i][e] -= mean; s2 += v[i][e] * v[i][e]; }
        const float rstd = 1.f / sqrtf(wave_sum(s2) * (1.f / D) + LN_EPS);
        const float* sh = mod + (size_t)(1 * 2 + b) * 6144; const float* sc = sh + 1024;
#pragma unroll
        for (int i = 0; i < 2; ++i) { const int col = 8 * lane + 512 * i; float x2[8];
#pragma unroll
            for (int q = 0; q < 2; ++q) { const f32x4 g4 = *(const f32x4*)(lg + col + 4 * q), b4 = *(const f32x4*)(lb + col + 4 * q);
#pragma unroll
                for (int e = 0; e < 4; ++e) x2[4 * q + e] = v[i][4 * q + e] * rstd * g4[e] + b4[e]; }
            if (fo) { *(f32x4*)(fo + (size_t)row * D + col) = (f32x4){x2[0], x2[1], x2[2], x2[3]}; *(f32x4*)(fo + (size_t)row * D + col + 4) = (f32x4){x2[4], x2[5], x2[6], x2[7]}; }
            else { u32x4 wx; wx.x = pg8c(x2[0], x2[1]); wx.y = pg8c(x2[2], x2[3]); wx.z = pg8c(x2[4], x2[5]); wx.w = pg8c(x2[6], x2[7]); *(u32x4*)(xo + (size_t)row * D + col) = wx;
                float h[8];
#pragma unroll
                for (int q = 0; q < 2; ++q) { const f32x4 s4 = *(const f32x4*)(sc + col + 4 * q), h4 = *(const f32x4*)(sh + col + 4 * q);
#pragma unroll
                    for (int e = 0; e < 4; ++e) h[4 * q + e] = x2[4 * q + e] * (s4[e] + 1.0f) + h4[e]; }
                u32x4 wh; wh.x = pg8c(h[0], h[1]); wh.y = pg8c(h[2], h[3]); wh.z = pg8c(h[4], h[5]); wh.w = pg8c(h[6], h[7]); *(u32x4*)(H + (size_t)row * D + col) = wh; } }
    }
}

namespace pg8 {
#define PG8_LAS __attribute__((address_space(3)))
typedef short bf16x8 __attribute__((ext_vector_type(8)));
typedef float f32x2 __attribute__((ext_vector_type(2)));
constexpr int BM = 256, BK = 64, HALF = 128, HTB = HALF * BK * 2  , STAGE_BYTES = 8 * HTB, NXCD = 8, WGM = 8;

__host__ __device__ __forceinline__ int lds_byte(int r, int c) { const int st = (r >> 4) * 2 + (c >> 5), rr = r & 15, cc = c & 31, ob = rr * 64 + cc * 2; return st * 1024 + (ob ^ (((ob >> 9) & 1) << 5)); }
__host__ __device__ __forceinline__ void stage_rc(int b, int& R, int& C) { const int st = b / 1024, sb = b % 1024, swz = sb ^ (((sb >> 9) & 1) << 5); R = (st >> 1) * 16 + swz / 64; C = (st & 1) * 32 + (swz % 64) / 2; }
__host__ __device__ __forceinline__ int perm32(int rho) { const int n = rho >> 4, i = rho & 15; return 8 * (i >> 2) + 4 * n + (i & 3); }

struct Unit { int pm, pn; };
struct Gemm { const bf16_t* A; const bf16_t* Bt; int lda, ldb, K; };

struct StaticOrder {
    static constexpr bool GATHER = false;
    int nM, nN, nwg, G, c;
    __device__ void init(int M, int N, int G_, int c_) { nM = M / BM; nN = N / BM; nwg = nM * nN; G = G_; c = c_; }
    __device__ bool next(int i, Unit& u) const {
        const long L = (long)i * G + c; if (L >= nwg) return false;
        int wgid = (int)L; { const int q = nwg / NXCD, r = nwg % NXCD, xcd = wgid % NXCD, off = wgid / NXCD; wgid = (xcd < r ? xcd * (q + 1) : r * (q + 1) + (xcd - r) * q) + off; }
        const int nig = WGM * nN, gid = wgid / nig, fm = gid * WGM, gsz = (nM - fm) < WGM ? (nM - fm) : WGM;
        u.pm = fm + ((wgid % nig) % gsz); u.pn = (wgid % nig) / gsz; return true;
    }
    __device__ __forceinline__ const char* abase(const Gemm& g, const Unit& u) const { return (const char*)g.A + (size_t)u.pm * BM * g.lda * 2; }
    __device__ __forceinline__ const char* bbase(const Gemm& g, const Unit& u) const { return (const char*)g.Bt + (size_t)u.pn * BM * g.ldb * 2; }
    __device__ __forceinline__ unsigned arow(const Unit&, int) const { return 0u; }
};
template <bool GATHER_, int NPN_LOG2> struct MoeOrder {
    static constexpr bool GATHER = GATHER_;
    const PG8_LAS int* tab; const int* list; size_t bstride; int G, c;
    __device__ bool next(int i, Unit& u) const { const int L = i * G + c; if (L >= (tab[0] << NPN_LOG2)) return false; u.pm = L >> NPN_LOG2; u.pn = L & ((1 << NPN_LOG2) - 1); return true; }
    __device__ __forceinline__ const char* abase(const Gemm& g, const Unit& u) const { return GATHER_ ? (const char*)g.A : (const char*)g.A + (size_t)u.pm * BM * g.lda * 2; }
    __device__ __forceinline__ const char* bbase(const Gemm& g, const Unit& u) const { return (const char*)g.Bt + (size_t)tab[64 + u.pm] * bstride + (size_t)u.pn * BM * g.ldb * 2; }
    __device__ __forceinline__ unsigned arow(const Unit& u, int r) const { const int e = tab[64 + u.pm], idx = tab[224 + u.pm] + r; return idx < tab[1 + e] ? (unsigned)(list[(size_t)e * T + idx] >> 1) : 0u; }
};

typedef __bf16 bf16x2_t __attribute__((ext_vector_type(2)));
__device__ __forceinline__ unsigned cvt_pk_bf16(float lo, float hi) { const f32x2 v = {lo, hi}; const bf16x2_t b = __builtin_convertvector(v, bf16x2_t); return __builtin_bit_cast(unsigned, b); }
__device__ __forceinline__ f32x2 gelu_pk(f32x2 v) {
    const f32x2 av = __builtin_elementwise_abs(v), d = av * 0.2316418882f + 1.0f;
    f32x2 t; t.x = __builtin_amdgcn_rcpf(d.x); t.y = __builtin_amdgcn_rcpf(d.y);
    f32x2 q = t * 0.5307027145f + (-0.7265760135f); q = q * t + 0.7107068705f; q = q * t + (-0.142248368f); q = q * t + 0.127414796f; q = q * t;
    const f32x2 s = (v * v) * (-0.72134752044f);
    f32x2 e; e.x = __builtin_amdgcn_exp2f(s.x); e.y = __builtin_amdgcn_exp2f(s.y);
    const f32x2 m = v * (q * e), r = v - m;
    f32x2 o; o.x = v.x < 0.f ? m.x : r.x; o.y = v.y < 0.f ? m.y : r.y; return o;
}

typedef f32x4 Acc[2][2][4][2];

struct EpiQKV {
    static constexpr bool PERM = true;
    const float* bias; const float* rc; const float* rs; bf16_t* Q; bf16_t* Kb; bf16_t* Vb;
    __device__ __forceinline__ void operator()(const Acc& acc, const Unit& u, int wr, int wc, int fr, int fq) const {
        const int tile = u.pn; int scol; bf16_t* dst; int ld; float sc = 1.f;
        if (tile < 4) { scol = (tile * 4 + wc) * 64; dst = Q + scol; ld = 1024; sc = QSCALE; }
        else if (tile == 4) { scol = 1024 + wc * 64; dst = Kb + wc * 64; ld = 256; }
        else { scol = 1280 + wc * 64; dst = Vb + wc * 64; ld = 256; }
        f32x4 b1[2], b2[2];
#pragma unroll
        for (int n = 0; n < 2; ++n) { b1[n] = *(const f32x4*)(bias + scol + 8 * fq + 4 * n); b2[n] = *(const f32x4*)(bias + scol + 32 + 8 * fq + 4 * n); }
#pragma unroll
        for (int ai = 0; ai < 2; ++ai)
#pragma unroll
            for (int m = 0; m < 4; ++m) {
                const int row = u.pm * BM + ai * HALF + wr * 64 + m * 16 + fr;
                f32x4 o1[2], o2[2];
#pragma unroll
                for (int n = 0; n < 2; ++n) {
                    const f32x4 x1 = acc[ai][0][m][n] + b1[n], x2 = acc[ai][1][m][n] + b2[n];
                    if (tile < 5) { const f32x4 cs = *(const f32x4*)(rc + (size_t)row * 32 + 8 * fq + 4 * n), sn = *(const f32x4*)(rs + (size_t)row * 32 + 8 * fq + 4 * n);
                        o1[n] = (x1 * cs - x2 * sn) * sc; o2[n] = (x2 * cs + x1 * sn) * sc; }
                    else { o1[n] = x1; o2[n] = x2; }
                }
                u32x4 w1, w2;
                w1.x = cvt_pk_bf16(o1[0][0], o1[0][1]); w1.y = cvt_pk_bf16(o1[0][2], o1[0][3]); w1.z = cvt_pk_bf16(o1[1][0], o1[1][1]); w1.w = cvt_pk_bf16(o1[1][2], o1[1][3]);
                w2.x = cvt_pk_bf16(o2[0][0], o2[0][1]); w2.y = cvt_pk_bf16(o2[0][2], o2[0][3]); w2.z = cvt_pk_bf16(o2[1][0], o2[1][1]); w2.w = cvt_pk_bf16(o2[1][2], o2[1][3]);
                bf16_t* rp = dst + (size_t)row * ld + 8 * fq;
                *(u32x4*)rp = w1; *(u32x4*)(rp + 32) = w2;
            }
    }
};
template <bool XBF> struct EpiResid {
    static constexpr bool PERM = true;
    const void* x; const float* bias; const float* gt; bf16_t* z;
    __device__ __forceinline__ void operator()(const Acc& acc, const Unit& u, int wr, int wc, int fr, int fq) const {
        const int col0 = u.pn * BM + wc * 32 + 8 * fq; const int b = (u.pm * BM) >> 13;
        f32x4 bv[2][2], gv[2][2];
#pragma unroll
        for (int bj = 0; bj < 2; ++bj)
#pragma unroll
            for (int n = 0; n < 2; ++n) { bv[bj][n] = *(const f32x4*)(bias + col0 + bj * HALF + 4 * n); gv[bj][n] = *(const f32x4*)(gt + b * 6144 + col0 + bj * HALF + 4 * n) + 1.0f; }
#pragma unroll
        for (int ai = 0; ai < 2; ++ai)
#pragma unroll
            for (int m = 0; m < 4; ++m) { const size_t off = (size_t)(u.pm * BM + ai * HALF + wr * 64 + m * 16 + fr) * D + col0;
#pragma unroll
                for (int bj = 0; bj < 2; ++bj) { f32x4 x0, x1;
                    if (XBF) { float f[8]; unpack8(*(const u32x4*)((const bf16_t*)x + off + bj * HALF), f); x0 = (f32x4){f[0], f[1], f[2], f[3]}; x1 = (f32x4){f[4], f[5], f[6], f[7]}; }
                    else { x0 = *(const f32x4*)((const float*)x + off + bj * HALF); x1 = *(const f32x4*)((const float*)x + off + bj * HALF + 4); }
                    const f32x4 z0 = x0 * ALPHA + gv[bj][0] * (acc[ai][bj][m][0] + bv[bj][0]), z1 = x1 * ALPHA + gv[bj][1] * (acc[ai][bj][m][1] + bv[bj][1]);
                    u32x4 w; w.x = cvt_pk_bf16(z0[0], z0[1]); w.y = cvt_pk_bf16(z0[2], z0[3]); w.z = cvt_pk_bf16(z1[0], z1[1]); w.w = cvt_pk_bf16(z1[2], z1[3]);
                    *(u32x4*)(z + off + bj * HALF) = w; }
                if (m & 1) asm volatile("" ::: "memory"); }
    }
};
struct EpiGeluUV {
    static constexpr bool PERM = true;
    const float* bias; bf16_t* U; bf16_t* V2; float* vstat;
    __device__ __forceinline__ void operator()(const Acc& acc, const Unit& u, int wr, int wc, int fr, int fq) const {
        const bool isv = u.pn >= 8; bf16_t* base = isv ? V2 : U; const int colt = (isv ? u.pn - 8 : u.pn) * BM;
        const int col0 = colt + wc * 32 + 8 * fq, bcol0 = u.pn * BM + wc * 32 + 8 * fq;
        f32x4 bv[2][2];
#pragma unroll
        for (int bj = 0; bj < 2; ++bj)
#pragma unroll
            for (int n = 0; n < 2; ++n) bv[bj][n] = *(const f32x4*)(bias + bcol0 + bj * HALF + 4 * n);
#pragma unroll
        for (int ai = 0; ai < 2; ++ai)
#pragma unroll
            for (int m = 0; m < 4; ++m) { const int row = u.pm * BM + ai * HALF + wr * 64 + m * 16 + fr; bf16_t* rowp = base + (size_t)row * GW + col0; float s = 0.f, s2 = 0.f;
#pragma unroll
                for (int bj = 0; bj < 2; ++bj) { f32x4 v0 = acc[ai][bj][m][0] + bv[bj][0], v1 = acc[ai][bj][m][1] + bv[bj][1];
                    const f32x2 a = gelu_pk((f32x2){v0[0], v0[1]}), bb = gelu_pk((f32x2){v0[2], v0[3]}), c = gelu_pk((f32x2){v1[0], v1[1]}), d = gelu_pk((f32x2){v1[2], v1[3]});
                    s += (a.x + a.y) + (bb.x + bb.y) + (c.x + c.y) + (d.x + d.y);
                    s2 += (a.x * a.x + a.y * a.y) + (bb.x * bb.x + bb.y * bb.y) + (c.x * c.x + c.y * c.y) + (d.x * d.x + d.y * d.y);
                    u32x4 w; w.x = cvt_pk_bf16(a.x, a.y); w.y = cvt_pk_bf16(bb.x, bb.y); w.z = cvt_pk_bf16(c.x, c.y); w.w = cvt_pk_bf16(d.x, d.y);
                    *(u32x4*)(rowp + bj * HALF) = w; }
                if (isv) { s += __shfl_xor(s, 16); s += __shfl_xor(s, 32); s2 += __shfl_xor(s2, 16); s2 += __shfl_xor(s2, 32);
                    if (fq == 0) *(f32x2*)(vstat + ((size_t)row * 32 + (u.pn - 8) * 4 + wc) * 2) = (f32x2){s, s2}; } }
    }
};
struct EpiMoe1 {
    static constexpr bool PERM = true;
    const PG8_LAS int* tab; const float* wl; bf16_t* act;
    __device__ __forceinline__ void operator()(const Acc& acc, const Unit& u, int wr, int wc, int fr, int fq) const {
        const int e = tab[64 + u.pm], r0 = tab[224 + u.pm], n_e = tab[1 + e];
        const int col0 = u.pn * HALF + wc * 32 + 8 * fq;
#pragma unroll
        for (int ai = 0; ai < 2; ++ai)
#pragma unroll
            for (int m = 0; m < 4; ++m) { const int rl = ai * HALF + wr * 64 + m * 16 + fr; const int idx = r0 + rl;
                const float w = idx < n_e ? wl[(size_t)e * T + idx] : 0.f;
                f32x4 o[2];
#pragma unroll
                for (int n = 0; n < 2; ++n) { const f32x4 g = acc[ai][0][m][n], up = acc[ai][1][m][n];
#pragma unroll
                    for (int i = 0; i < 4; ++i) { const float sg = g[i] * __builtin_amdgcn_rcpf(1.f + __builtin_amdgcn_exp2f(-g[i] * LOG2E)); o[n][i] = idx < n_e ? sg * up[i] * w : 0.f; } }
                u32x4 wv; wv.x = cvt_pk_bf16(o[0][0], o[0][1]); wv.y = cvt_pk_bf16(o[0][2], o[0][3]); wv.z = cvt_pk_bf16(o[1][0], o[1][1]); wv.w = cvt_pk_bf16(o[1][2], o[1][3]);
                *(u32x4*)(act + (size_t)(u.pm * BM + rl) * EFF + col0) = wv; }
    }
};
struct EpiMoe2 {
    static constexpr bool PERM = true;
    const PG8_LAS int* tab; const int* list; bf16_t* y2;
    __device__ __forceinline__ void operator()(const Acc& acc, const Unit& u, int wr, int wc, int fr, int fq) const {
        const int e = tab[64 + u.pm], r0 = tab[224 + u.pm], n_e = tab[1 + e];
        const int col0 = u.pn * BM + wc * 32 + 8 * fq; const int* lp = list + (size_t)e * T + r0 + wr * 64 + fr;
#pragma unroll
        for (int ai = 0; ai < 2; ++ai) {
            int ts[4];
#pragma unroll
            for (int m = 0; m < 4; ++m) { const int idx = r0 + ai * HALF + wr * 64 + m * 16 + fr; ts[m] = idx < n_e ? lp[ai * HALF + m * 16] : -1; }
#pragma unroll
            for (int m = 0; m < 4; ++m) {
                if (ts[m] >= 0) { bf16_t* rowp = y2 + (size_t)ts[m] * D + col0;
#pragma unroll
                    for (int bj = 0; bj < 2; ++bj) { const f32x4 v0 = acc[ai][bj][m][0], v1 = acc[ai][bj][m][1];
                        u32x4 w; w.x = cvt_pk_bf16(v0[0], v0[1]); w.y = cvt_pk_bf16(v0[2], v0[3]); w.z = cvt_pk_bf16(v1[0], v1[1]); w.w = cvt_pk_bf16(v1[2], v1[3]);
                        *(u32x4*)(rowp + bj * HALF) = w; } }
                asm volatile("" ::: "memory"); }
        }
    }
};

template <class Epi, class Sched, bool ALIGN_EPI>
__device__ __forceinline__ void gemm_phase(PG8_LAS unsigned char* lds, const Gemm g, const Sched& S, const Epi& E) {
    const int tid = fresh_tid();
    const int wid = __builtin_amdgcn_readfirstlane(tid >> 6), lane = tid & 63, wr = wid >> 2, wc = wid & 3, fr = lane & 15, fq = lane >> 4;
    const int K = g.K, nt = K / BK;
    int RA[2], CA[2]; unsigned voffB[2][2], cvA[2][2], nvA[2][2];
#pragma unroll
    for (int i = 0; i < 2; ++i) { int R, C; stage_rc(tid * 16 + i * 8192, R, C); const int Rb = Epi::PERM ? ((R & ~31) + perm32(R & 31)) : R; RA[i] = R; CA[i] = C;
#pragma unroll
        for (int h = 0; h < 2; ++h) { voffB[h][i] = (unsigned)((Rb + h * HALF) * g.ldb + C) * 2u; cvA[h][i] = (unsigned)((R + h * HALF) * g.lda + C) * 2u; nvA[h][i] = cvA[h][i]; } }
    const size_t kstep = (size_t)(BK * 2);
    const unsigned ldsw = (unsigned)wid * 1024u;
    const int aoff = lds_byte(wr * 64 + fr, fq * 8), boff = lds_byte(wc * 32 + fr, fq * 8);
#define PG8_SA(b, h) (((b) * 2 + (h)) * HTB)
#define PG8_SB(b, h) ((4 + (b) * 2 + (h)) * HTB)
#define PG8_STAGE(bufoff, gbase, voff) do { _Pragma("unroll") for (int _i = 0; _i < 2; ++_i) \
        __builtin_amdgcn_global_load_lds((const unsigned*)((const char*)(gbase) + (voff)[_i]), (PG8_LAS unsigned*)(lds + (bufoff) + ldsw + _i * 8192), 16, 0, 0); } while (0)
#define PG8_LDA(dst, b, h) do { _Pragma("unroll") for (int m = 0; m < 4; ++m) _Pragma("unroll") for (int k = 0; k < 2; ++k) dst[m][k] = *(const PG8_LAS bf16x8*)(lds + PG8_SA(b, h) + aoff + m * 2048 + k * 1024); } while (0)
#define PG8_LDB(dst, b, h) do { _Pragma("unroll") for (int n = 0; n < 2; ++n) _Pragma("unroll") for (int k = 0; k < 2; ++k) dst[n][k] = *(const PG8_LAS bf16x8*)(lds + PG8_SB(b, h) + boff + n * 2048 + k * 1024); } while (0)
#define PG8_MMA(ai, bj, At, Bt) do { __builtin_amdgcn_s_setprio(1); _Pragma("unroll") for (int m = 0; m < 4; ++m) _Pragma("unroll") for (int n = 0; n < 2; ++n) _Pragma("unroll") for (int k = 0; k < 2; ++k) \
        acc[ai][bj][m][n] = __builtin_amdgcn_mfma_f32_16x16x32_bf16(Bt[n][k], At[m][k], acc[ai][bj][m][n], 0, 0, 0); __builtin_amdgcn_s_setprio(0); } while (0)
#define PG8_WAIT_V(n) asm volatile("s_waitcnt vmcnt(" #n ")" ::: "memory")
#define PG8_WAIT_L(n) asm volatile("s_waitcnt lgkmcnt(" #n ")" ::: "memory")
#define PG8_BAR __builtin_amdgcn_s_barrier()
#define PG8_SCHED __builtin_amdgcn_sched_barrier(0)
#define PG8_GATHER(dst, un) do { _Pragma("unroll") for (int _i = 0; _i < 2; ++_i) _Pragma("unroll") for (int _h = 0; _h < 2; ++_h) dst[_h][_i] = (S.arow(un, _h * HALF + RA[_i]) * (unsigned)g.lda + (unsigned)CA[_i]) * 2u; } while (0)
    Unit cur, nxt; int ui = 0;
    if (!S.next(0, cur)) return;
    Acc acc;
#pragma unroll
    for (int a = 0; a < 2; ++a)
#pragma unroll
        for (int b = 0; b < 2; ++b)
#pragma unroll
            for (int m = 0; m < 4; ++m)
#pragma unroll
                for (int n = 0; n < 2; ++n) acc[a][b][m][n] = (f32x4){0.f, 0.f, 0.f, 0.f};
    bf16x8 At[4][2], B0[2][2], B1[2][2];
    if constexpr (Sched::GATHER) { PG8_GATHER(cvA, cur); }
    const char* cA = S.abase(g, cur); const char* cB = S.bbase(g, cur);
    PG8_STAGE(PG8_SB(0, 0), cB, voffB[0]); PG8_STAGE(PG8_SB(0, 1), cB, voffB[1]); PG8_STAGE(PG8_SA(0, 0), cA, cvA[0]); PG8_STAGE(PG8_SA(0, 1), cA, cvA[1]);
    if (wr == 1) PG8_BAR;
    PG8_WAIT_V(2); PG8_BAR;
    PG8_STAGE(PG8_SB(1, 0), cB + kstep, voffB[0]); PG8_STAGE(PG8_SA(1, 0), cA + kstep, cvA[0]); PG8_STAGE(PG8_SB(1, 1), cB + kstep, voffB[1]);
    PG8_WAIT_V(6); PG8_BAR;
    for (;;) {
        const bool has_next = S.next(ui + 1, nxt);
        if constexpr (Sched::GATHER) { if (has_next) { PG8_GATHER(nvA, nxt); } else {
#pragma unroll
            for (int i = 0; i < 2; ++i) { nvA[0][i] = cvA[0][i]; nvA[1][i] = cvA[1][i]; } } }
        const char* nA = has_next ? S.abase(g, nxt) : cA; const char* nB = has_next ? S.bbase(g, nxt) : cB;
#pragma unroll 1
        for (int t = 0; t < nt; t += 2) {
            const bool last = (t == nt - 2);
            const char* a1 = cA + (size_t)(t + 1) * kstep;
            const char* a2 = last ? nA : cA + (size_t)(t + 2) * kstep; const char* b2 = last ? nB : cB + (size_t)(t + 2) * kstep;
            const char* a3 = a2 + kstep; const char* b3 = b2 + kstep;
            unsigned wA[2][2];
#pragma unroll
            for (int i = 0; i < 2; ++i) { wA[0][i] = (Sched::GATHER && last) ? nvA[0][i] : cvA[0][i]; wA[1][i] = (Sched::GATHER && last) ? nvA[1][i] : cvA[1][i]; }
            PG8_LDB(B0, 0, 0); PG8_LDB(B1, 0, 1); PG8_SCHED; PG8_LDA(At, 0, 0); PG8_STAGE(PG8_SA(1, 1), a1, cvA[1]);
            PG8_WAIT_V(8); PG8_WAIT_L(0); PG8_BAR; PG8_MMA(0, 0, At, B0); PG8_MMA(0, 1, At, B1); PG8_BAR; PG8_SCHED;
            PG8_LDA(At, 0, 1); PG8_STAGE(PG8_SB(0, 0), b2, voffB[0]); PG8_STAGE(PG8_SB(0, 1), b2, voffB[1]); PG8_STAGE(PG8_SA(0, 0), a2, wA[0]);
            PG8_WAIT_V(8); PG8_WAIT_L(0); PG8_BAR; PG8_MMA(1, 0, At, B0); PG8_MMA(1, 1, At, B1); PG8_BAR; PG8_SCHED;
            PG8_LDB(B0, 1, 0); PG8_LDB(B1, 1, 1); PG8_SCHED; PG8_LDA(At, 1, 0); PG8_STAGE(PG8_SA(0, 1), a2, wA[1]);
            PG8_WAIT_V(8); PG8_WAIT_L(0); PG8_BAR; PG8_MMA(0, 0, At, B0); PG8_MMA(0, 1, At, B1); PG8_BAR; PG8_SCHED;
            PG8_LDA(At, 1, 1); PG8_STAGE(PG8_SB(1, 0), b3, voffB[0]); PG8_STAGE(PG8_SB(1, 1), b3, voffB[1]); PG8_STAGE(PG8_SA(1, 0), a3, wA[0]);
            PG8_WAIT_V(8); PG8_WAIT_L(0); PG8_BAR; PG8_MMA(1, 0, At, B0); PG8_MMA(1, 1, At, B1); PG8_BAR; PG8_SCHED;
        }
        if constexpr (ALIGN_EPI) { if (wr == 0) PG8_BAR; }
        E(acc, cur, wr, wc, fr, fq);
        if (!has_next) break;
#pragma unroll
        for (int a = 0; a < 2; ++a)
#pragma unroll
            for (int b = 0; b < 2; ++b)
#pragma unroll
                for (int m = 0; m < 4; ++m)
#pragma unroll
                    for (int n = 0; n < 2; ++n) acc[a][b][m][n] = (f32x4){0.f, 0.f, 0.f, 0.f};
        cur = nxt; cA = nA; cB = nB; ++ui;
#pragma unroll
        for (int i = 0; i < 2; ++i) { cvA[0][i] = nvA[0][i]; cvA[1][i] = nvA[1][i]; }
        if constexpr (ALIGN_EPI) { if (wr == 1) PG8_BAR; }
    }
    PG8_WAIT_V(0);
    if constexpr (!ALIGN_EPI) { if (wr == 0) PG8_BAR; }
    PG8_BAR;
#undef PG8_SA
#undef PG8_SB
#undef PG8_STAGE
#undef PG8_LDA
#undef PG8_LDB
#undef PG8_MMA
#undef PG8_WAIT_V
#undef PG8_WAIT_L
#undef PG8_BAR
#undef PG8_SCHED
#undef PG8_GATHER
}
}


namespace attn {
typedef float f32x16 __attribute__((ext_vector_type(16)));
typedef short bf16x8 __attribute__((ext_vector_type(8)));
typedef short s16x4 __attribute__((ext_vector_type(4)));
constexpr int KSTR = 144, VSTR = 192;
constexpr int LDS_K = 0, LDS_V = 256 * KSTR, LDS_END = LDS_V + 256 * VSTR;
__device__ __forceinline__ int crow(int i, int h) { return (i & 3) + 8 * (i >> 2) + 4 * h; }
__device__ __forceinline__ s16x4 vtr(const PG8_LAS unsigned char* p) { return __builtin_bit_cast(s16x4, __builtin_amdgcn_ds_read_tr16_b64_v4i16((__attribute__((address_space(3))) s16x4*)p)); }

__device__ __forceinline__ void attn_phase(const Params& p, PG8_LAS unsigned char* lds, int bid, int G) {
    const int tid = fresh_tid(), wid = __builtin_amdgcn_readfirstlane(tid >> 6), lane = tid & 63, r = lane & 31, h = lane >> 5;
    const bf16_t* Q = (const bf16_t*)(p.ws + WS_RA + RA_Q); const bf16_t* Kb = (const bf16_t*)(p.ws + WS_RA + RA_K); const bf16_t* Vb = (const bf16_t*)(p.ws + WS_RA + RA_V);
    bf16_t* O = (bf16_t*)(p.ws + WS_RA + RA_O);
#pragma unroll 1
    for (int unit = bid; unit < 512; unit += G) {
        const int kvh = unit & 3, qblk = (unit >> 2) & 63, b = unit >> 8;
        const size_t row0 = (size_t)b * SEQ + (size_t)qblk * 128;
        __syncthreads();
#pragma unroll
        for (int i = 0; i < 4; ++i) { const int pc = i * 512 + tid, key = pc >> 3, c = pc & 7;
            u32x4 kv = (u32x4){0u, 0u, 0u, 0u}, vv = (u32x4){0u, 0u, 0u, 0u};
            if (qblk > 0 || key >= 128) { const size_t gr = row0 + key - 128; kv = *(const u32x4*)(Kb + gr * 256 + kvh * 64 + c * 8); vv = *(const u32x4*)(Vb + gr * 256 + kvh * 64 + c * 8); }
            *(PG8_LAS u32x4*)(lds + LDS_K + key * KSTR + c * 16) = kv; *(PG8_LAS u32x4*)(lds + LDS_V + key * VSTR + c * 16) = vv; }
        __syncthreads();
        const int hq = kvh * 4 + (wid >> 1), qhalf = wid & 1;
        const float sink = p.in[9][hq] * LOG2E;
#pragma unroll 1
        for (int qt = 0; qt < 2; ++qt) {
            const int q0 = qhalf * 64 + qt * 32, kt0 = q0 >> 5;
            bf16x8 qf[4]; const bf16_t* qp = Q + (row0 + q0 + r) * 1024 + hq * 64 + h * 8;
#pragma unroll
            for (int d0 = 0; d0 < 4; ++d0) qf[d0] = *(const bf16x8*)(qp + d0 * 16);
            f32x16 s[5];
#pragma unroll
            for (int t = 0; t < 5; ++t) {
#pragma unroll
                for (int i = 0; i < 16; ++i) s[t][i] = 0.f;
                const PG8_LAS unsigned char* kp = lds + LDS_K + (32 * (kt0 + t) + r) * KSTR + h * 16;
#pragma unroll
                for (int d0 = 0; d0 < 4; ++d0) { const bf16x8 kf = *(const PG8_LAS bf16x8*)(kp + d0 * 32); s[t] = __builtin_amdgcn_mfma_f32_32x32x16_bf16(kf, qf[d0], s[t], 0, 0, 0); }
            }
#pragma unroll
            for (int i = 0; i < 16; ++i) { const int kk = crow(i, h); s[0][i] = kk > r ? s[0][i] : -INFINITY; s[4][i] = kk <= r ? s[4][i] : -INFINITY; }
            if (qblk == 0) {
#pragma unroll
                for (int t = 0; t < 4; ++t) if (kt0 + t < 4) {
#pragma unroll
                    for (int i = 0; i < 16; ++i) s[t][i] = -INFINITY; }
            }
            float m = sink;
#pragma unroll
            for (int t = 0; t < 5; ++t)
#pragma unroll
                for (int i = 0; i < 16; ++i) m = fmaxf(m, s[t][i]);
            m = fmaxf(m, __shfl_xor(m, 32));
            float sum = 0.f;
#pragma unroll
            for (int t = 0; t < 5; ++t)
#pragma unroll
                for (int i = 0; i < 16; ++i) { s[t][i] = __builtin_amdgcn_exp2f(s[t][i] - m); sum += s[t][i]; }
            sum += __shfl_xor(sum, 32); sum += __builtin_amdgcn_exp2f(sink - m);
            const float rinv = 1.f / sum;
            f32x16 o[2];
#pragma unroll
            for (int i = 0; i < 16; ++i) { o[0][i] = 0.f; o[1][i] = 0.f; }
#pragma unroll
            for (int t = 0; t < 5; ++t)
#pragma unroll
                for (int ss = 0; ss < 2; ++ss) {
                    u32x4 pw; pw.x = pg8::cvt_pk_bf16(s[t][8 * ss] * rinv, s[t][8 * ss + 1] * rinv); pw.y = pg8::cvt_pk_bf16(s[t][8 * ss + 2] * rinv, s[t][8 * ss + 3] * rinv);
                    pw.z = pg8::cvt_pk_bf16(s[t][8 * ss + 4] * rinv, s[t][8 * ss + 5] * rinv); pw.w = pg8::cvt_pk_bf16(s[t][8 * ss + 6] * rinv, s[t][8 * ss + 7] * rinv);
                    const bf16x8 pa = __builtin_bit_cast(bf16x8, pw);
                    const PG8_LAS unsigned char* vp = lds + LDS_V + (32 * (kt0 + t) + 16 * ss + 4 * h + ((lane & 15) >> 2)) * VSTR + (16 * ((lane >> 4) & 1) + 4 * (lane & 3)) * 2;
#pragma unroll
                    for (int d0 = 0; d0 < 2; ++d0) { const s16x4 lo = vtr(vp + d0 * 64), hi = vtr(vp + d0 * 64 + 8 * VSTR);
                        const bf16x8 vb = (bf16x8){lo[0], lo[1], lo[2], lo[3], hi[0], hi[1], hi[2], hi[3]};
                        o[d0] = __builtin_amdgcn_mfma_f32_32x32x16_bf16(pa, vb, o[d0], 0, 0, 0); }
                }
            bf16_t* op = O + (row0 + q0) * 1024 + hq * 64 + r;
#pragma unroll
            for (int i = 0; i < 16; ++i) { const int q = crow(i, h); op[(size_t)q * 1024] = (bf16_t)(pg8::cvt_pk_bf16(o[0][i], 0.f) & 0xffffu); op[(size_t)q * 1024 + 32] = (bf16_t)(pg8::cvt_pk_bf16(o[1][i], 0.f) & 0xffffu); }
        }
    }
    __syncthreads();
}
}

namespace sgu {
typedef float f32x16 __attribute__((ext_vector_type(16)));
typedef short bf16x8 __attribute__((ext_vector_type(8)));
typedef short s16x4 __attribute__((ext_vector_type(4)));
constexpr int WSTR = 272, VSTR = 576;
constexpr int LDS_W = 0, LDS_VN = 128 * WSTR, LDS_ST = LDS_VN + 128 * VSTR, LDS_BS = LDS_ST + 128 * 8, LDS_END = LDS_BS + 512;
__device__ __forceinline__ void gate_phase(const Params& p, PG8_LAS unsigned char* lds, int bid, int G) {
    const int tid = fresh_tid(), wid = __builtin_amdgcn_readfirstlane(tid >> 6), lane = tid & 63, r = lane & 31, h = lane >> 5;
    const bf16_t* U = (const bf16_t*)(p.ws + WS_RA + RA_U); const bf16_t* V2 = (const bf16_t*)(p.ws + WS_RA + RA_V2); bf16_t* GT = (bf16_t*)(p.ws + WS_RA + RA_GATED);
    const bf16_t* Wsb = (const bf16_t*)(p.ws + WS_WS); const float* vstat = (const float*)(p.ws + WS_VSTAT);
    PG8_LAS float* st = (PG8_LAS float*)(lds + LDS_ST); PG8_LAS float* bs = (PG8_LAS float*)(lds + LDS_BS);
#pragma unroll 1
    for (int unit = bid; unit < 1024; unit += G) {
        const int g = unit & 7, chunk = unit >> 3; const size_t row0 = (size_t)chunk * 128;
        __syncthreads();
        { const int row = tid >> 2, qd = tid & 3; const float* ps = vstat + ((row0 + row) * 32 + qd * 8) * 2; float a = 0.f, a2 = 0.f;
#pragma unroll
            for (int i = 0; i < 4; ++i) { const f32x4 v = *(const f32x4*)(ps + 4 * i); a += v.x + v.z; a2 += v.y + v.w; }
            a += __shfl_xor(a, 1); a += __shfl_xor(a, 2); a2 += __shfl_xor(a2, 1); a2 += __shfl_xor(a2, 2);
            const float mean = a * (1.f / GW), var = fmaxf(a2 * (1.f / GW) - mean * mean, 0.f);
            if (qd == 0) { st[row * 2] = mean; st[row * 2 + 1] = 1.f / sqrtf(var + LN_EPS); }
            if (tid < 128) bs[tid] = p.in[17][g * 128 + tid]; }
#pragma unroll
        for (int i = 0; i < 4; ++i) { const int pc = i * 512 + tid, t = pc >> 4, c = pc & 15;
            *(PG8_LAS u32x4*)(lds + LDS_W + t * WSTR + c * 16) = *(const u32x4*)(Wsb + (size_t)(g * 128 + t) * 128 + c * 8); }
        __syncthreads();
        { const int c = tid & 31; const int col = g * 256 + c * 8;
            const f32x4 g0 = *(const f32x4*)(p.in[14] + col), g1 = *(const f32x4*)(p.in[14] + col + 4), b0 = *(const f32x4*)(p.in[15] + col), b1 = *(const f32x4*)(p.in[15] + col + 4);
#pragma unroll
            for (int i = 0; i < 8; ++i) { const int srow = i * 16 + (tid >> 5);
                const u32x4 v = *(const u32x4*)(V2 + (row0 + srow) * GW + col); const float mu = st[srow * 2], rs = st[srow * 2 + 1];
                f32x4 x0, x1; x0.x = __builtin_bit_cast(float, v.x << 16); x0.y = __builtin_bit_cast(float, v.x & 0xffff0000u); x0.z = __builtin_bit_cast(float, v.y << 16); x0.w = __builtin_bit_cast(float, v.y & 0xffff0000u);
                x1.x = __builtin_bit_cast(float, v.z << 16); x1.y = __builtin_bit_cast(float, v.z & 0xffff0000u); x1.z = __builtin_bit_cast(float, v.w << 16); x1.w = __builtin_bit_cast(float, v.w & 0xffff0000u);
                x0 = (x0 - mu) * rs * g0 + b0; x1 = (x1 - mu) * rs * g1 + b1;
                u32x4 w; w.x = pg8::cvt_pk_bf16(x0.x, x0.y); w.y = pg8::cvt_pk_bf16(x0.z, x0.w); w.z = pg8::cvt_pk_bf16(x1.x, x1.y); w.w = pg8::cvt_pk_bf16(x1.z, x1.w);
                *(PG8_LAS u32x4*)(lds + LDS_VN + srow * VSTR + c * 16) = w; } }
        __syncthreads();
        bf16x8 bf[8];
        { const PG8_LAS unsigned char* vp = lds + LDS_VN + (8 * h + ((lane & 15) >> 2)) * VSTR + (32 * wid + 16 * ((lane >> 4) & 1) + 4 * (lane & 3)) * 2;
#pragma unroll
            for (int ks = 0; ks < 8; ++ks) { const s16x4 lo = attn::vtr(vp + ks * 16 * VSTR), hi = attn::vtr(vp + ks * 16 * VSTR + 4 * VSTR);
                bf[ks] = (bf16x8){lo[0], lo[1], lo[2], lo[3], hi[0], hi[1], hi[2], hi[3]}; } }
#pragma unroll
        for (int tt = 0; tt < 4; ++tt) {
            f32x16 acc;
#pragma unroll
            for (int i = 0; i < 16; ++i) acc[i] = 0.f;
            const PG8_LAS unsigned char* wp = lds + LDS_W + (32 * tt + r) * WSTR + h * 16;
#pragma unroll
            for (int ks = 0; ks < 2 * tt + 2; ++ks) { const bf16x8 af = *(const PG8_LAS bf16x8*)(wp + ks * 32); acc = __builtin_amdgcn_mfma_f32_32x32x16_bf16(af, bf[ks], acc, 0, 0, 0); }
            const size_t obase = (row0 + 32 * tt) * GW + g * 256 + 32 * wid + r;
#pragma unroll
            for (int i = 0; i < 16; ++i) { const int t = attn::crow(i, h); const float mixed = acc[i] + bs[32 * tt + t];
                const float u = bf2f(U[obase + (size_t)t * GW]); GT[obase + (size_t)t * GW] = (bf16_t)(pg8::cvt_pk_bf16(u * mixed, 0.f) & 0xffffu); }
        }
    }
    __syncthreads();
}
}

#define XB_TMO      128
#define XB_XCNT(j)  (256  + 64 * (j))
#define XB_XSUB(j)  (1280 + 64 * (j))
#define XB_XGEN(j)  (2304 + 64 * (j))
#define XB_TOP      3328
#define XB_TOPGEN   3392
#define XCD_BAR_WORDS 3456
#define XB_SPIN_CAP (1u << 18)

__device__ __forceinline__ unsigned xb_ld(unsigned* p)              { return __hip_atomic_load(p, __ATOMIC_RELAXED, __HIP_MEMORY_SCOPE_AGENT); }
__device__ __forceinline__ unsigned xb_add(unsigned* p, unsigned v) { return __hip_atomic_fetch_add(p, v, __ATOMIC_RELAXED, __HIP_MEMORY_SCOPE_AGENT); }
__device__ __forceinline__ unsigned xb_xcc_id() { return (unsigned)__builtin_amdgcn_s_getreg((3 << 11) | 20) & 0xFu; }
#define XB_SPIN(cond, bar) do { unsigned _sp = 0; while (cond) { __builtin_amdgcn_s_sleep(1); \
    if ((++_sp & 255u) == 0u) { if (xb_ld(&(bar)[XB_TMO])) break; if (_sp > XB_SPIN_CAP) { atomicAdd(&(bar)[XB_TMO], 1u); break; } } } } while (0)

struct XcdBarrier {
    unsigned* bar; unsigned x;
    volatile PG8_LAS unsigned* st;
};

__device__ __forceinline__ XcdBarrier xcd_barrier_post(unsigned* bar, volatile PG8_LAS unsigned* st) {
    XcdBarrier b; b.bar = bar; b.x = xb_xcc_id(); b.st = st;
    if (threadIdx.x == 0) (void)xb_add(&bar[XB_XCNT(b.x)], 1u);
    return b;
}
__device__ __forceinline__ void xcd_barrier_complete(unsigned* bar, unsigned x, unsigned& nloc, unsigned& nx) {
    const unsigned G = gridDim.x * gridDim.y * gridDim.z;
    unsigned sum, cnt, mine, sp = 0u;
    for (;;) {
        sum = 0u; cnt = 0u; mine = 0u;
#pragma unroll
        for (unsigned j = 0; j < 16; ++j) { const unsigned c = xb_ld(&bar[XB_XCNT(j)]); sum += c; cnt += (c > 0u) ? 1u : 0u; mine = (j == x) ? c : mine; }
        if (sum == G) break;
        __builtin_amdgcn_s_sleep(1);
        if ((++sp & 255u) == 0u) { if (xb_ld(&bar[XB_TMO])) break; if (sp > XB_SPIN_CAP) { atomicAdd(&bar[XB_TMO], 1u); break; } }
    }
    nloc = mine > 0u ? mine : 1u; nx = cnt > 0u ? cnt : 1u;
}

__device__ __forceinline__ void xcd_barrier(const XcdBarrier& b) {
    asm volatile("s_waitcnt vmcnt(0)" ::: "memory");
    __syncthreads();
    if (threadIdx.x == 0) {
        unsigned* bar = b.bar;
        __builtin_amdgcn_s_waitcnt(0);
        unsigned nloc = b.st[0], nx = b.st[1];
        if (nloc == 0u) { xcd_barrier_complete(bar, b.x, nloc, nx); b.st[0] = nloc; b.st[1] = nx; }
        const unsigned old = xb_add(&bar[XB_XSUB(b.x)], 1u);
        const unsigned gen = old / nloc;
        if (old + 1u == (gen + 1u) * nloc) {
            __builtin_amdgcn_fence(__ATOMIC_RELEASE, "agent");
            asm volatile("s_waitcnt vmcnt(0)" ::: "memory");
            const unsigned og = xb_add(&bar[XB_TOP], 1u);
            const unsigned tg = og / nx;
            if (og + 1u == (tg + 1u) * nx) xb_add(&bar[XB_TOPGEN], 1u);
            else XB_SPIN(xb_ld(&bar[XB_TOPGEN]) == tg, bar);
            __builtin_amdgcn_fence(__ATOMIC_ACQUIRE, "agent");
            xb_add(&bar[XB_XGEN(b.x)], 1u);
            asm volatile("s_waitcnt vmcnt(0)" ::: "memory");
        } else {
            XB_SPIN(xb_ld(&bar[XB_XGEN(b.x)]) == gen, bar);
            __builtin_amdgcn_fence(__ATOMIC_ACQUIRE, "agent");
            asm volatile("s_waitcnt vmcnt(0)" ::: "memory");
        }
    }
    __syncthreads();
}

constexpr int LDS_BYTES = 152 * 1024, MISC_OFF = 147456;
struct MArgs { Params p; int lo, hi, li, pad; };
constexpr int NPHASE = 16;
#ifndef PROF_MASK
#define PROF_MASK 0u
#endif
#ifndef PROF_SYNC
#define PROF_SYNC 0
#endif

__device__ __forceinline__ void moe_build_tab(const Params& p, int l, PG8_LAS int* tab) {
    const int tid = fresh_tid();
    if (tid < 64) {
        const int n = tid < 32 ? ((const int*)(p.ws + WS_CTL))[l * 32 + tid] : 0; const int ntl = (n + 255) >> 8;
        int incl = ntl;
#pragma unroll
        for (int o = 1; o < 64; o <<= 1) { const int v = __shfl_up(incl, o); if (tid >= o) incl += v; }
        const int off = incl - ntl;
        if (tid < 32) { tab[1 + tid] = n; for (int j = 0; j < ntl; ++j) { tab[64 + off + j] = tid; tab[224 + off + j] = j * 256; } }
        if (tid == 31) tab[0] = incl;
    }
    __syncthreads();
}

__global__ void __launch_bounds__(512, 2) mega(MArgs a) {
    extern __shared__ __attribute__((aligned(16))) unsigned char lds_raw[];
    PG8_LAS unsigned char* lds = (PG8_LAS unsigned char*)lds_raw;
    PG8_LAS int* tab = (PG8_LAS int*)(lds + MISC_OFF);
    const Params& p = a.p; unsigned char* ws = p.ws;
    const int lo = a.lo, hi = a.hi, G = gridDim.x, bid = blockIdx.x;
    volatile PG8_LAS unsigned* bst = (volatile PG8_LAS unsigned*)(lds + MISC_OFF + 2048);
    if (threadIdx.x < 2) bst[threadIdx.x] = 0u;
    __syncthreads();
    XcdBarrier xbar = xcd_barrier_post((unsigned*)(ws + WS_CTL + 16384) + a.li * XCD_BAR_WORDS, bst);
    bf16_t* Z = (bf16_t*)p.out; bf16_t* X1 = (bf16_t*)(ws + WS_X1); bf16_t* X2 = (bf16_t*)(ws + WS_X2); const float* mod = (const float*)(ws + WS_MOD);
    bf16_t* H = (bf16_t*)(ws + WS_H);
#ifndef TESTPH
#define TESTPH -1
#endif
#define INC(c, k) ((TESTPH < 0 || TESTPH == (c)) && lo <= (k) && (k) < hi)
#define IN(k) INC(k, k)
#define REPS(k) (((PROF_MASK >> (k)) & 1u) ? 2 : 1)
#define SEAM(k) do { if (lo <= (k) && (k) + 1 < hi) { for (int _r = 0; _r <= PROF_SYNC; ++_r) xcd_barrier(xbar); } } while (0)
#define MOE_BLOCK(l, pb) { \
        const int* list = (const int*)(ws + WS_LIST) + (size_t)(l) * 32 * T; const float* wl = (const float*)(ws + WS_WL) + (size_t)(l) * 32 * T; \
        if (INC(5, (pb) + 5)) { for (int rep = 0; rep < REPS((pb) + 5); ++rep) { phase_ln_router(p, (l), Z, X1, bid, G, (float*)lds_raw, rep == 0); __syncthreads(); } } SEAM((pb) + 5); \
        if (INC(6, (pb) + 6)) for (int rep = 0; rep < REPS((pb) + 6); ++rep) { \
            moe_build_tab(p, (l), tab); \
            pg8::Gemm g{H, (const bf16_t*)(ws + WS_WGU) + (size_t)(l) * 32 * 512 * 1024, D, D, D}; \
            pg8::MoeOrder<true, 1> S{tab, list, (size_t)512 * 1024 * 2, G, bid}; \
            pg8::EpiMoe1 E{tab, wl, (bf16_t*)(ws + WS_RA + RA_ACT)}; \
            pg8::gemm_phase<pg8::EpiMoe1, pg8::MoeOrder<true, 1>, true>(lds, g, S, E); \
        } SEAM((pb) + 6); \
        if (INC(7, (pb) + 7)) for (int rep = 0; rep < REPS((pb) + 7); ++rep) { \
            moe_build_tab(p, (l), tab); \
            pg8::Gemm g{(const bf16_t*)(ws + WS_RA + RA_ACT), (const bf16_t*)(ws + WS_WD) + (size_t)(l) * 32 * 1024 * 256, EFF, EFF, EFF}; \
            pg8::MoeOrder<false, 2> S{tab, list, (size_t)1024 * 256 * 2, G, bid}; \
            pg8::EpiMoe2 E{tab, list, (bf16_t*)(ws + WS_RA + RA_Y2)}; \
            pg8::gemm_phase<pg8::EpiMoe2, pg8::MoeOrder<false, 2>, true>(lds, g, S, E); \
        } SEAM((pb) + 7); \
        if (INC(8, (pb) + 8)) { for (int rep = 0; rep < REPS((pb) + 8); ++rep) phase_ln2(p, (l), X1, X2, (l) == 0 ? nullptr : p.out, bid, G); } SEAM((pb) + 8); }
    if (IN(0)) { for (int rep = 0; rep < REPS(0); ++rep) { p0_prologue(p, bid, G, (float*)lds_raw); __syncthreads(); } } SEAM(0);
    if (IN(1)) { for (int rep = 0; rep < REPS(1); ++rep) phase_h0(p, bid, G); } SEAM(1);
    if (IN(2)) for (int rep = 0; rep < REPS(2); ++rep) {
        pg8::Gemm g{H, (const bf16_t*)(ws + WS_WQKV), D, D, D}; pg8::StaticOrder S; S.init(T, NQKV, G, bid);
        pg8::EpiQKV E{p.in[8], (const float*)(ws + WS_ROPE_C), (const float*)(ws + WS_ROPE_S), (bf16_t*)(ws + WS_RA + RA_Q), (bf16_t*)(ws + WS_RA + RA_K), (bf16_t*)(ws + WS_RA + RA_V)};
        pg8::gemm_phase<pg8::EpiQKV, pg8::StaticOrder, true>(lds, g, S, E);
    } SEAM(2);
    if (IN(3)) { for (int rep = 0; rep < REPS(3); ++rep) attn::attn_phase(p, lds, bid, G); } SEAM(3);
    if (IN(4)) for (int rep = 0; rep < REPS(4); ++rep) {
        pg8::Gemm g{(const bf16_t*)(ws + WS_RA + RA_O), (const bf16_t*)(ws + WS_WO), D, D, D}; pg8::StaticOrder S; S.init(T, D, G, bid);
        pg8::EpiResid<false> E{p.in[0], p.in[11], mod + 2 * 1024, Z};
        pg8::gemm_phase<pg8::EpiResid<false>, pg8::StaticOrder, true>(lds, g, S, E);
    } SEAM(4);
    MOE_BLOCK(0, 0)
    if (IN(9)) for (int rep = 0; rep < REPS(9); ++rep) {
        pg8::Gemm g{H, (const bf16_t*)(ws + WS_WIN), D, D, D}; pg8::StaticOrder S; S.init(T, 2 * GW, G, bid);
        pg8::EpiGeluUV E{p.in[13], (bf16_t*)(ws + WS_RA + RA_U), (bf16_t*)(ws + WS_RA + RA_V2), (float*)(ws + WS_VSTAT)};
        pg8::gemm_phase<pg8::EpiGeluUV, pg8::StaticOrder, true>(lds, g, S, E);
    } SEAM(9);
    if (IN(10)) { for (int rep = 0; rep < REPS(10); ++rep) sgu::gate_phase(p, lds, bid, G); } SEAM(10);
    if (IN(11)) for (int rep = 0; rep < REPS(11); ++rep) {
        pg8::Gemm g{(const bf16_t*)(ws + WS_RA + RA_GATED), (const bf16_t*)(ws + WS_WOUT), GW, GW, GW}; pg8::StaticOrder S; S.init(T, D, G, bid);
        pg8::EpiResid<true> E{X2, p.in[19], mod + 2 * 6144 + 2 * 1024, Z};
        pg8::gemm_phase<pg8::EpiResid<true>, pg8::StaticOrder, true>(lds, g, S, E);
    } SEAM(11);
    MOE_BLOCK(1, 7)
#undef IN
#undef SEAM
#undef MOE_BLOCK
}

extern "C" void kernel_launch(void* const* d_in, const int* in_sizes, int n_in, void* d_out, int out_size, void* d_ws, size_t ws_size, hipStream_t stream) {
    if (n_in != 26 || out_size != T * D || ws_size < WS_END) { fprintf(stderr, "kernel_launch: unexpected problem (n_in %d out %d ws %zu)\n", n_in, out_size, ws_size); return; }
    static int grid = 0;
    if (!grid) {
        (void)hipFuncSetAttribute((const void*)mega, hipFuncAttributeMaxDynamicSharedMemorySize, LDS_BYTES);
        int dev = 0, cus = 0, per_cu = 0;
        (void)hipGetDevice(&dev); (void)hipDeviceGetAttribute(&cus, hipDeviceAttributeMultiprocessorCount, dev);
        (void)hipOccupancyMaxActiveBlocksPerMultiprocessor(&per_cu, (const void*)mega, 512, LDS_BYTES);
        if (per_cu < 1) { fprintf(stderr, "kernel_launch: occupancy query says %d blocks per CU; launching one per CU anyway\n", per_cu); }
        grid = cus;
    }
    Params p{};
    for (int i = 0; i < 26; ++i) p.in[i] = (const float*)d_in[i];
    p.out = (float*)d_out; p.ws = (unsigned char*)d_ws;
    (void)hipMemsetAsync(p.ws + WS_CTL, 0, 64 * 1024, stream);
    MArgs ma{p, 0, NPHASE, 0, 0};
    hipLaunchKernelGGL(mega, dim3(grid), dim3(512), LDS_BYTES, stream, ma);
}
```
